# Optimizing an MI355X kernel written in HIP

```python
import jax, jax.numpy as jnp
from jax import lax
import numpy as np

D_MODEL = 2048
BATCH = 8
SEQ = 2048
DEPTH = 1

D_MIX = D_MODEL
ROPE_THETA = 10000.0
RMS_EPS = 1e-6
NEG_INF = -1e30
TINY = 1e-30
Q_BLOCK = 128

WIDTH_A = D_MIX // 2
HEAD_DIM_A = 128
N_HEADS_A = WIDTH_A // HEAD_DIM_A
N_KV_A = 2
GROUP_A = N_HEADS_A // N_KV_A
KV_A = N_KV_A * HEAD_DIM_A
CMP_BLOCK = 32
CMP_STRIDE = 16
CMP_HIDDEN = 256
SEL_BLOCK = 64
SEL_TOPK = 16
SEL_Q_CHUNK = 32
WIN_A = 512
FORCE_SCORE = 1e4

WIDTH_B = D_MIX - WIDTH_A
HEAD_DIM_B = 64
N_HEADS_B = WIDTH_B // HEAD_DIM_B
N_KV_B = 2
GROUP_B = N_HEADS_B // N_KV_B
KV_B = N_KV_B * HEAD_DIM_B
WIN_B = 128

IN_SIZES = (WIDTH_A, KV_A, KV_A, KV_A, KV_A, KV_A, KV_A, WIDTH_A, 3 * N_HEADS_A,
            WIDTH_B, KV_B, KV_B, WIDTH_B)
D_IN = 2 * WIDTH_A + 6 * KV_A + 3 * N_HEADS_A + 2 * WIDTH_B + 2 * KV_B

kernel_name = 'nsa_swa_sink_hybrid_block'


def _rmsnorm(x, g):
    xf = x.astype(jnp.float32)
    y = xf * lax.rsqrt(jnp.mean(xf * xf, axis=-1, keepdims=True) + RMS_EPS)
    return (y * g.astype(jnp.float32)).astype(x.dtype)


def _heads(t, n, d):
    return t.reshape(t.shape[0], t.shape[1], n, d)


def _rope(x):
    S, d = x.shape[1], x.shape[-1]
    inv = ROPE_THETA ** (-jnp.arange(0, d, 2, dtype=jnp.float32) / d)
    ang = jnp.arange(S, dtype=jnp.float32)[:, None] * inv[None, :]
    cos = jnp.cos(ang)[None, :, None, :]
    sin = jnp.sin(ang)[None, :, None, :]
    xf = x.astype(jnp.float32)
    x1, x2 = xf[..., : d // 2], xf[..., d // 2:]
    return jnp.concatenate([x1 * cos - x2 * sin, x2 * cos + x1 * sin], axis=-1).astype(x.dtype)


def _masked_softmax(s, mask, sink=None):
    s = jnp.where(mask, s.astype(jnp.float32), NEG_INF)
    m = jnp.max(s, axis=-1, keepdims=True)
    if sink is not None:
        m = jnp.maximum(m, sink)
    e = jnp.where(mask, jnp.exp(s - m), 0.0)
    denom = jnp.sum(e, axis=-1, keepdims=True)
    if sink is not None:
        denom = denom + jnp.exp(sink - m)
    return e / jnp.maximum(denom, TINY)


def _compress(kv, pos_emb, w1, w2):
    B, S, Hkv, D = kv.shape
    n_c = (S - CMP_BLOCK) // CMP_STRIDE + 1
    idx = jnp.arange(n_c)[:, None] * CMP_STRIDE + jnp.arange(CMP_BLOCK)[None, :]
    blocks = kv[:, idx] + pos_emb[None, None, :, None, :].astype(kv.dtype)
    flat = blocks.transpose(0, 1, 3, 2, 4).reshape(B, n_c, Hkv, CMP_BLOCK * D)
    return jax.nn.silu(flat @ w1) @ w2


def _compressed_attention(q, kc, vc):
    S, D = q.shape[1], q.shape[-1]
    n_c = kc.shape[1]
    s = jnp.einsum('bskgd,bckd->bkgsc', q, kc) * (D ** -0.5)
    ends = jnp.arange(n_c) * CMP_STRIDE + CMP_BLOCK - 1
    mask = ends[None, :] <= jnp.arange(S)[:, None]
    p = _masked_softmax(s, mask)
    o = jnp.einsum('bkgsc,bckd->bskgd', p.astype(vc.dtype), vc)
    return o, p


def _select_blocks(p_cmp, S):
    n_c = p_cmp.shape[-1]
    n_sel = S // SEL_BLOCK
    c_start = np.arange(n_c) * CMP_STRIDE
    j_start = np.arange(n_sel) * SEL_BLOCK
    overlap = (c_start[:, None] < j_start[None, :] + SEL_BLOCK) & (c_start[:, None] + CMP_BLOCK > j_start[None, :])
    p_sel = jnp.einsum('bkgsc,cj->bksj', p_cmp, jnp.asarray(overlap, jnp.float32))
    t = jnp.arange(S)[:, None]
    j = jnp.arange(n_sel)[None, :]
    cur = t // SEL_BLOCK
    forced = (j == 0) | (j == cur) | (j == cur - 1)
    valid = j * SEL_BLOCK <= t
    score = jnp.where(forced, FORCE_SCORE, jnp.where(valid, p_sel, -1.0))
    _, idx = lax.top_k(score, min(SEL_TOPK, n_sel))
    return idx


def _selected_attention(q, k, v, idx):
    B, S, Hkv, G, D = q.shape
    K = idx.shape[-1]
    n_sel = S // SEL_BLOCK
    n_ch = S // SEL_Q_CHUNK
    kb = k.reshape(B, n_sel, SEL_BLOCK, Hkv, D).transpose(0, 3, 1, 2, 4)
    vb = v.reshape(B, n_sel, SEL_BLOCK, Hkv, D).transpose(0, 3, 1, 2, 4)
    gather = jax.vmap(jax.vmap(lambda blocks, i: blocks[i]))
    scale = D ** -0.5

    def chunk_fn(args):
        qc, ic, tc = args
        kg = gather(kb, ic)
        vg = gather(vb, ic)
        s = jnp.einsum('bckgd,bkcnld->bkgcnl', qc, kg) * scale
        tok = ic[..., None] * SEL_BLOCK + jnp.arange(SEL_BLOCK)
        mask = (tok <= tc[None, None, :, None, None])[:, :, None]
        C = qc.shape[1]
        p = _masked_softmax(s.reshape(B, Hkv, G, C, K * SEL_BLOCK), mask.reshape(B, Hkv, 1, C, K * SEL_BLOCK))
        p = p.reshape(B, Hkv, G, C, K, SEL_BLOCK)
        return jnp.einsum('bkgcnl,bkcnld->bckgd', p.astype(vg.dtype), vg)

    qs = jnp.moveaxis(q.reshape(B, n_ch, SEL_Q_CHUNK, Hkv, G, D), 1, 0)
    ids = jnp.moveaxis(idx.reshape(B, Hkv, n_ch, SEL_Q_CHUNK, K), 2, 0)
    ts = jnp.arange(S).reshape(n_ch, SEL_Q_CHUNK)
    o = lax.map(chunk_fn, (qs, ids, ts))
    return jnp.moveaxis(o, 0, 1).reshape(B, S, Hkv, G, D)


def _banded_attention(q, k, v, window, sink=None):
    B, S, Hkv, G, D = q.shape
    nq = S // Q_BLOCK
    kv_len = window + Q_BLOCK
    pad = ((0, 0), (window, 0), (0, 0), (0, 0))
    idx = jnp.arange(nq)[:, None] * Q_BLOCK + jnp.arange(kv_len)[None, :]
    kb = jnp.pad(k, pad)[:, idx]
    vb = jnp.pad(v, pad)[:, idx]
    qb = q.reshape(B, nq, Q_BLOCK, Hkv, G, D)
    s = jnp.einsum('bnqkgd,bnjkd->bnkgqj', qb, kb) * (D ** -0.5)
    key_pos = idx - window
    q_pos = jnp.arange(S).reshape(nq, Q_BLOCK)
    diff = q_pos[:, :, None] - key_pos[:, None, :]
    mask = ((diff >= 0) & (diff < window) & (key_pos[:, None, :] >= 0))[None, :, None, None]
    sink_b = None if sink is None else sink.astype(jnp.float32)[None, None, :, :, None, None]
    p = _masked_softmax(s, mask, sink_b)
    o = jnp.einsum('bnkgqj,bnjkd->bnqkgd', p.astype(vb.dtype), vb)
    return o.reshape(B, S, Hkv, G, D)


def setup_inputs(seed: int = 0) -> dict:
    key = jax.random.key(seed)
    ks = jax.random.split(key, 12)

    def nrm(k, shape, scale):
        return jax.random.normal(k, shape, jnp.float32) * scale

    flat_in = CMP_BLOCK * HEAD_DIM_A
    return {
        'x': nrm(ks[0], (BATCH, SEQ, D_MODEL), 1.0),
        'w_in': nrm(ks[1], (DEPTH, D_MODEL, D_IN), D_MODEL ** -0.5),
        'cmp_k_w1': nrm(ks[2], (DEPTH, flat_in, CMP_HIDDEN), flat_in ** -0.5),
        'cmp_k_w2': nrm(ks[3], (DEPTH, CMP_HIDDEN, HEAD_DIM_A), CMP_HIDDEN ** -0.5),
        'cmp_v_w1': nrm(ks[4], (DEPTH, flat_in, CMP_HIDDEN), flat_in ** -0.5),
        'cmp_v_w2': nrm(ks[5], (DEPTH, CMP_HIDDEN, HEAD_DIM_A), CMP_HIDDEN ** -0.5),
        'cmp_k_pos': nrm(ks[6], (DEPTH, CMP_BLOCK, HEAD_DIM_A), 0.1),
        'cmp_v_pos': nrm(ks[7], (DEPTH, CMP_BLOCK, HEAD_DIM_A), 0.1),
        'sinks': nrm(ks[8], (DEPTH, N_HEADS_B), 1.0),
        'w_out': nrm(ks[9], (DEPTH, D_MIX, D_MODEL), D_MIX ** -0.5),
        'norm_g': 1.0 + nrm(ks[10], (DEPTH, D_MODEL), 0.01),
        'final_g': 1.0 + nrm(ks[11], (D_MODEL,), 0.01),
    }


def reference(x, w_in, cmp_k_w1, cmp_k_w2, cmp_v_w1, cmp_v_w2, cmp_k_pos, cmp_v_pos, sinks, w_out, norm_g, final_g):
    B, S, _ = x.shape
    offsets = np.cumsum(IN_SIZES)[:-1].tolist()
    for l in range(DEPTH):
        h = _rmsnorm(x, norm_g[l])
        proj = h @ w_in[l]
        (qa, kca, vca, ksa, vsa, kwa, vwa, za, ga,
         qb, kb, vb, zb) = jnp.split(proj, offsets, axis=-1)

        qa = _rope(_heads(qa, N_HEADS_A, HEAD_DIM_A)).reshape(B, S, N_KV_A, GROUP_A, HEAD_DIM_A)
        kc = _compress(_rope(_heads(kca, N_KV_A, HEAD_DIM_A)), cmp_k_pos[l], cmp_k_w1[l], cmp_k_w2[l])
        vc = _compress(_heads(vca, N_KV_A, HEAD_DIM_A), cmp_v_pos[l], cmp_v_w1[l], cmp_v_w2[l])
        o_cmp, p_cmp = _compressed_attention(qa, kc, vc)
        sel_idx = _select_blocks(p_cmp, S)
        o_sel = _selected_attention(qa, _rope(_heads(ksa, N_KV_A, HEAD_DIM_A)), _heads(vsa, N_KV_A, HEAD_DIM_A), sel_idx)
        o_win = _banded_attention(qa, _rope(_heads(kwa, N_KV_A, HEAD_DIM_A)), _heads(vwa, N_KV_A, HEAD_DIM_A), WIN_A)
        gates = jax.nn.sigmoid(ga.astype(jnp.float32)).reshape(B, S, N_KV_A, GROUP_A, 3).astype(x.dtype)
        o_a = gates[..., 0:1] * o_cmp + gates[..., 1:2] * o_sel + gates[..., 2:3] * o_win
        y_a = o_a.reshape(B, S, WIDTH_A) * jax.nn.silu(za)

        qb = _rope(_heads(qb, N_HEADS_B, HEAD_DIM_B)).reshape(B, S, N_KV_B, GROUP_B, HEAD_DIM_B)
        o_b = _banded_attention(qb, _rope(_heads(kb, N_KV_B, HEAD_DIM_B)), _heads(vb, N_KV_B, HEAD_DIM_B),
                                WIN_B, sink=sinks[l].reshape(N_KV_B, GROUP_B))
        y_b = o_b.reshape(B, S, WIDTH_B) * jax.nn.silu(zb)

        x = x + jnp.concatenate([y_a, y_b], axis=-1) @ w_out[l]
    return _rmsnorm(x, final_g)
```

```cpp
#include <hip/hip_runtime.h>
#include <hip/hip_cooperative_groups.h>
#include <cstdio>
namespace cg = cooperative_groups;

#ifndef MULTI_LAUNCH
#define MULTI_LAUNCH 0
#endif

typedef unsigned short bf16_t;
typedef short bf16x8 __attribute__((ext_vector_type(8)));
typedef float f32x4 __attribute__((ext_vector_type(4)));
typedef unsigned u32x4 __attribute__((ext_vector_type(4)));
typedef float f32x16 __attribute__((ext_vector_type(16)));
#define DI __device__ __forceinline__
#define MFMA16(a, b, c) __builtin_amdgcn_mfma_f32_16x16x32_bf16((a), (b), (c), 0, 0, 0)
#define MFMA32(a, b, c) __builtin_amdgcn_mfma_f32_32x32x16_bf16((a), (b), (c), 0, 0, 0)
#define WAIT_V0() asm volatile("s_waitcnt vmcnt(0)" ::: "memory")

constexpr int NTHR = 512;
constexpr int T_TOK = 16384, SEQ = 2048, DM = 2048;
constexpr int N1 = 6144;
constexpr float LOG2E = 1.4426950408889634f;

struct Params {
  const float *x, *w_in, *k_w1, *k_w2, *v_w1, *v_w2, *k_pos, *v_pos, *sinks, *w_out, *norm_g, *final_g;
  float* out;
  char* ws;
  int wv;
  int pad_;
};

constexpr size_t MiB = 1u << 20;
constexpr size_t OFF_HB = 0, OFF_WTIN = 64 * MiB, OFF_WTOUT = 88 * MiB, OFF_W1T = 96 * MiB, OFF_W2T = 100 * MiB, OFF_MISC = 101 * MiB,
                 OFF_QA = 104 * MiB, OFF_KCA = 136 * MiB, OFF_VCA = 144 * MiB, OFF_KSA = 152 * MiB, OFF_VSAT = 160 * MiB, OFF_KWA = 168 * MiB,
                 OFF_VWAT = 176 * MiB, OFF_ZA = 184 * MiB, OFF_GATES = 216 * MiB, OFF_QB = 218 * MiB, OFF_KB = 250 * MiB, OFF_VBT = 254 * MiB,
                 OFF_ZB = 258 * MiB, OFF_KC = 290 * MiB, OFF_VCT = 291 * MiB, OFF_OWIN = 292 * MiB, OFF_Y = 324 * MiB;
constexpr size_t OFF_BAR = 103 * MiB;
constexpr size_t OFF_CPART = 400 * MiB;
constexpr size_t MISC_CTR = 0, MISC_ROWSS = 4096, MISC_BIASP = 128 * 1024, MISC_TAB128 = 256 * 1024, MISC_TAB64 = 256 * 1024 + MiB;

constexpr int SHM_BYTES = 157696;
__shared__ __attribute__((aligned(1024))) char g_shm[SHM_BYTES];

DI unsigned short f2bf(float x) {
  unsigned u = __float_as_uint(x);
  u += 0x7fffu + ((u >> 16) & 1u);
  return (unsigned short)(u >> 16);
}
typedef __bf16 hbf16x2 __attribute__((ext_vector_type(2)));
typedef float f32x2 __attribute__((ext_vector_type(2)));
DI unsigned pack2(float a, float b) {
  f32x2 v = {a, b};
  return __builtin_bit_cast(unsigned, __builtin_convertvector(v, hbf16x2));
}
DI float silu_f(float v) { return v / (1.f + __expf(-v)); }
DI float sigmoid_f(float v) { return 1.f / (1.f + __expf(-v)); }
DI float ex2(float v) { return __builtin_amdgcn_exp2f(v); }
DI int crow(int i, int hh) { return (i & 3) + 8 * (i >> 2) + 4 * hh; }
DI float dpp_xor1(float v) { return __int_as_float(__builtin_amdgcn_mov_dpp(__float_as_int(v), 0xB1, 0xF, 0xF, true)); }
DI float dpp_xor2(float v) { return __int_as_float(__builtin_amdgcn_mov_dpp(__float_as_int(v), 0x4E, 0xF, 0xF, true)); }
DI float xhalf(float v, int r, int hh) {
  int rr = r;
  asm volatile("" : "+v"(rr));
  return __int_as_float(__builtin_amdgcn_ds_bpermute((rr | ((hh ^ 1) << 5)) << 2, __float_as_int(v)));
}
DI int olane() {
  int l;
  asm volatile("v_mbcnt_lo_u32_b32 %0, -1, 0\n\tv_mbcnt_hi_u32_b32 %0, -1, %0" : "=v"(l));
  return l;
}
DI int otid(int wv) { return (wv << 6) | olane(); }
DI float swz_xor(float v, int k) { return v; }
#define SWZ_XOR_F(v, k) __int_as_float(__builtin_amdgcn_ds_swizzle(__float_as_int(v), ((k) << 10) | 0x1F))
#define SWZ_XOR_U(v, k) ((unsigned)__builtin_amdgcn_ds_swizzle((int)(v), ((k) << 10) | 0x1F))

DI int win_col(int np) {
  if (np >= 5912) return -1;
  if (np >= 5888) return np - 5888 + 3584;
  if (np >= 3584) return np + 24;
  bool roped = (np < 1280) || (np >= 1536 && np < 1792) || (np >= 2048 && np < 2304);
  if (!roped) return np;
  int base = np & ~127, pp = np & 127;
  int w = pp >> 6, n = (pp >> 4) & 3, fr = pp & 15;
  int d = ((n & 2) ? 64 : 0) + 32 * w + 16 * (n & 1) + fr;
  return base + d;
}

struct TDesc { const float* src; bf16_t* dst; int ld_src, ld_dst, k0, n0, mode; };
DI void tile_load(const TDesc& d, int tid, f32x4& v0, f32x4& v1) {
  const int n4 = tid & 15, kr = tid >> 4;
  int np = d.n0 + 4 * n4;
  int oc = np;
  if (d.mode == 1) {
    const int q = np & 255;
    np = (np & ~255) + ((q >> 5) & 3) * 64 + (q >> 7) * 32 + ((q >> 4) & 1) * 16 + (q & 15);
    oc = win_col(np);
  }
  v0 = f32x4{0.f, 0.f, 0.f, 0.f};
  v1 = f32x4{0.f, 0.f, 0.f, 0.f};
  if (oc >= 0) {
    v0 = __builtin_nontemporal_load((const f32x4*)(d.src + (size_t)(d.k0 + kr) * d.ld_src + oc));
    v1 = __builtin_nontemporal_load((const f32x4*)(d.src + (size_t)(d.k0 + kr + 32) * d.ld_src + oc));
  }
}
DI void tile_finish(const TDesc& d, int tid, const f32x4& v0, const f32x4& v1) {
  float* tile = (float*)g_shm;
  {
    const int n4 = tid & 15, kr = tid >> 4;
#pragma unroll
    for (int e = 0; e < 4; ++e) {
      tile[(4 * n4 + e) * 65 + kr] = v0[e];
      tile[(4 * n4 + e) * 65 + kr + 32] = v1[e];
    }
  }
  __syncthreads();
  {
    const int k8 = tid & 7, n = tid >> 3;
    const float* t = tile + n * 65 + k8 * 8;
    u32x4 o;
    o[0] = pack2(t[0], t[1]);
    o[1] = pack2(t[2], t[3]);
    o[2] = pack2(t[4], t[5]);
    o[3] = pack2(t[6], t[7]);
    *(u32x4*)(d.dst + (size_t)(d.n0 + n) * d.ld_dst + d.k0 + k8 * 8) = o;
  }
  __syncthreads();
}
DI void tile_decode(const Params& p, int it, TDesc& d) {
  constexpr int I_WIN = 96 * 32, I_WOUT = 32 * 32, I_W1 = 4 * 64, I_W2 = 2 * 4;
  int i = it;
  if (i < I_WIN) { d = TDesc{p.w_in, (bf16_t*)(p.ws + OFF_WTIN), 5912, 2048, (i & 31) * 64, (i >> 5) * 64, 1}; return; }
  i -= I_WIN;
  if (i < I_WOUT) { d = TDesc{p.w_out, (bf16_t*)(p.ws + OFF_WTOUT), 2048, 2048, (i & 31) * 64, (i >> 5) * 64, 0}; return; }
  i -= I_WOUT;
  if (i < 2 * I_W1) {
    const int mat = i / I_W1; i %= I_W1;
    d = TDesc{mat ? p.v_w1 : p.k_w1, (bf16_t*)(p.ws + OFF_W1T) + (size_t)mat * 256 * 4096, 256, 4096, (i & 63) * 64, (i >> 6) * 64, 0};
    return;
  }
  i -= 2 * I_W1;
  {
    const int mat = i / I_W2; i %= I_W2;
    d = TDesc{mat ? p.v_w2 : p.k_w2, (bf16_t*)(p.ws + OFF_W2T) + (size_t)mat * 128 * 256, 128, 256, (i & 3) * 64, (i >> 2) * 64, 0};
  }
}

DI void phase_prep(const Params& p) {
  const int tid = otid(p.wv), wid = tid >> 6, lane = tid & 63;
  char* misc = p.ws + OFF_MISC;
  for (int i = blockIdx.x * NTHR + tid; i < 1024 + T_TOK; i += gridDim.x * NTHR) ((float*)misc)[i] = 0.f;
  {
    float2* t128 = (float2*)(misc + MISC_TAB128);
    for (int i = blockIdx.x * NTHR + tid; i < SEQ * 64; i += gridDim.x * NTHR) {
      int pos = i >> 6, f = i & 63;
      float inv = (float)exp2(-(double)(2 * f) / 128.0 * 13.287712379549449);
      float ang = (float)pos * inv;
      double a = (double)ang;
      double kk = rint(a * 0.15915494309189535);
      float rr = (float)(a - kk * 6.283185307179586);
      t128[i] = make_float2(cosf(rr), sinf(rr));
    }
    float2* t64 = (float2*)(misc + MISC_TAB64);
    for (int i = blockIdx.x * NTHR + tid; i < SEQ * 32; i += gridDim.x * NTHR) {
      int pos = i >> 5, f = i & 31;
      float inv = (float)exp2(-(double)(2 * f) / 64.0 * 13.287712379549449);
      float ang = (float)pos * inv;
      double a = (double)ang;
      double kk = rint(a * 0.15915494309189535);
      float rr = (float)(a - kk * 6.283185307179586);
      t64[i] = make_float2(cosf(rr), sinf(rr));
    }
  }
  {
    bf16_t* hb = (bf16_t*)(p.ws + OFF_HB);
    const float4* g4 = (const float4*)p.norm_g;
    f32x4 nx[8];
    {
      const int row0 = blockIdx.x * 8 + wid;
      if (row0 < T_TOK) {
#pragma unroll
        for (int i = 0; i < 8; ++i) nx[i] = __builtin_nontemporal_load((const f32x4*)(p.x + (size_t)row0 * DM + (lane + 64 * i) * 4));
      }
    }
    for (int row = blockIdx.x * 8 + wid; row < T_TOK; row += gridDim.x * 8) {
      float4 v[8];
      float ss = 0.f;
#pragma unroll
      for (int i = 0; i < 8; ++i) {
        v[i] = make_float4(nx[i][0], nx[i][1], nx[i][2], nx[i][3]);
        ss += v[i].x * v[i].x + v[i].y * v[i].y + v[i].z * v[i].z + v[i].w * v[i].w;
      }
      {
        const int rown = row + gridDim.x * 8;
        if (rown < T_TOK) {
#pragma unroll
          for (int i = 0; i < 8; ++i) nx[i] = __builtin_nontemporal_load((const f32x4*)(p.x + (size_t)rown * DM + (lane + 64 * i) * 4));
        }
      }
      ss += SWZ_XOR_F(ss, 1); ss += SWZ_XOR_F(ss, 2); ss += SWZ_XOR_F(ss, 4); ss += SWZ_XOR_F(ss, 8); ss += SWZ_XOR_F(ss, 16);
      ss += xhalf(ss, lane & 31, lane >> 5);
      float rstd = rsqrtf(ss * (1.f / DM) + 1e-6f);
#pragma unroll
      for (int i = 0; i < 8; ++i) {
        float4 g = g4[lane + 64 * i];
        uint2 o;
        o.x = pack2(v[i].x * rstd * g.x, v[i].y * rstd * g.y);
        o.y = pack2(v[i].z * rstd * g.z, v[i].w * rstd * g.w);
        *(uint2*)(hb + (size_t)row * DM + (lane + 64 * i) * 4) = o;
      }
    }
  }
  {
    constexpr int TOT = 96 * 32 + 32 * 32 + 2 * 4 * 64 + 2 * 2 * 4;
    int it = blockIdx.x;
    TDesc d{}, dn{};
    f32x4 v0, v1, w0, w1;
    if (it < TOT) { tile_decode(p, it, d); tile_load(d, tid, v0, v1); }
    while (it < TOT) {
      const int itn = it + gridDim.x;
      dn = d; w0 = v0; w1 = v1;
      if (itn < TOT) { tile_decode(p, itn, dn); tile_load(dn, tid, w0, w1); }
      tile_finish(d, tid, v0, v1);
      d = dn; v0 = w0; v1 = w1;
      it = itn;
    }
  }
  {
    float* biasp = (float*)(misc + MISC_BIASP);
    float* red = (float*)g_shm;
    for (int it = blockIdx.x; it < 32; it += gridDim.x) {
      int mat = it >> 4, ch = it & 15;
      const float* w1 = mat ? p.v_w1 : p.k_w1;
      const float* pos = mat ? p.v_pos : p.k_pos;
      int n = tid & 255, half = tid >> 8;
      int kb = ch * 256 + half * 128;
      float a = 0.f;
#pragma unroll
      for (int kk = 0; kk < 128; kk += 32) {
        float wv_[32];
#pragma unroll
        for (int u = 0; u < 32; ++u) wv_[u] = w1[(size_t)(kb + kk + u) * 256 + n];
#pragma unroll
        for (int u = 0; u < 32; ++u) a += pos[kb + kk + u] * wv_[u];
      }
      red[tid] = a;
      __syncthreads();
      if (tid < 256) biasp[(mat * 16 + ch) * 256 + tid] = red[tid] + red[tid + 256];
      __syncthreads();
    }
  }
}

DI int lds_byte(int r, int c) {
  int st = (r >> 4) * 2 + (c >> 5), ob = (r & 15) * 64 + (c & 31) * 2;
  return st * 1024 + (ob ^ (((ob >> 9) & 1) << 5));
}
DI void stage_rc(int b, int& R, int& C) {
  int st = b >> 10, sb = b & 1023, swz = sb ^ (((sb >> 9) & 1) << 5);
  R = (st >> 1) * 16 + swz / 64;
  C = (st & 1) * 32 + (swz % 64) / 2;
}

template <bool TRANS = false>
DI void gemm_mainloop(int wv, const bf16_t* __restrict__ Ab, int lda, const bf16_t* __restrict__ Bb, int ldb, int nt, f32x4 (&acc)[8][4], bool active = true) {
  const int tid = otid(wv), wid = tid >> 6, lane = tid & 63, wr = wid >> 2, wc = wid & 3, fr = lane & 15, fq = lane >> 4;
  int sR[4], sC[4];
#pragma unroll
  for (int i = 0; i < 4; ++i) stage_rc(wid * 1024 + i * 8192 + lane * 16, sR[i], sC[i]);
#pragma unroll
  for (int m = 0; m < 8; ++m)
#pragma unroll
    for (int n = 0; n < 4; ++n) acc[m][n] = f32x4{0.f, 0.f, 0.f, 0.f};
#define SA(b) (g_shm + (b) * 65536)
#define SB(b) (g_shm + (b) * 65536 + 32768)
#define GLDS_STAGE(buf, kt)                                                                                                   \
  do {                                                                                                                        \
    _Pragma("unroll") for (int i = 0; i < 4; ++i) {                                                                            \
      __builtin_amdgcn_global_load_lds((const unsigned*)(Ab + (size_t)sR[i] * lda + (kt) * 64 + sC[i]),                        \
                                       (unsigned*)(SA(buf) + wid * 1024 + i * 8192), 16, 0, 0);                                \
      __builtin_amdgcn_global_load_lds((const unsigned*)(Bb + (size_t)sR[i] * ldb + (kt) * 64 + sC[i]),                        \
                                       (unsigned*)(SB(buf) + wid * 1024 + i * 8192), 16, 0, 0);                                \
    }                                                                                                                         \
  } while (0)
#define KSTEP(buf, ks)                                                                                                        \
  do {                                                                                                                        \
    bf16x8 At[8], Bf[4];                                                                                                      \
    _Pragma("unroll") for (int m = 0; m < 8; ++m) At[m] = *(const bf16x8*)(SA(buf) + lds_byte(wr * 128 + m * 16 + fr, (ks) * 32 + fq * 8)); \
    _Pragma("unroll") for (int n = 0; n < 4; ++n) Bf[n] = *(const bf16x8*)(SB(buf) + lds_byte(wc * 64 + n * 16 + fr, (ks) * 32 + fq * 8));  \
    __builtin_amdgcn_s_setprio(1);                                                                                            \
    _Pragma("unroll") for (int m = 0; m < 8; ++m) _Pragma("unroll") for (int n = 0; n < 4; ++n) acc[m][n] = TRANS ? MFMA16(Bf[n], At[m], acc[m][n]) : MFMA16(At[m], Bf[n], acc[m][n]); \
    __builtin_amdgcn_s_setprio(0);                                                                                            \
    __builtin_amdgcn_sched_barrier(0);                                                                                        \
  } while (0)
  GLDS_STAGE(0, 0);
  WAIT_V0();
  __syncthreads();
  for (int t = 0; t < nt; ++t) {
    int cur = t & 1;
    if (t + 1 < nt) GLDS_STAGE(cur ^ 1, t + 1);
    if (active) {
      KSTEP(cur, 0);
      KSTEP(cur, 1);
    }
    WAIT_V0();
    __syncthreads();
  }
#undef KSTEP
#undef GLDS_STAGE
}

#define ROWM(m) ((((m) >> 2) * 128) + wr * 64 + (((m) & 3) * 16))
#define COLN(n) ((((n) >> 1) * 128) + wc * 32 + (((n) & 1) * 16))
template <bool TRANS, bool GATED = false>
DI void gemm_mainloop8(int wv, const bf16_t* __restrict__ A, int lda, const bf16_t* __restrict__ Bt, int ldb, int nt, f32x4 (&acc)[8][4], bool active = true) {
  const int tid = otid(wv), wid = tid >> 6, lane = tid & 63, wr = wid >> 2, wc = wid & 3, fr = lane & 15, fq = lane >> 4;
#define SA8(b, h) (g_shm + ((b) * 2 + (h)) * 16384)
#define SB8(b, h) (g_shm + (4 + (b) * 2 + (h)) * 16384)
  unsigned offA0, offA1, offB0, offB1;
  {
    int r0, c0, r1, c1;
    stage_rc(tid * 16, r0, c0);
    stage_rc(tid * 16 + 8192, r1, c1);
    offA0 = (unsigned)(r0 * lda + c0); offA1 = (unsigned)(r1 * lda + c1);
    offB0 = (unsigned)(r0 * ldb + c0); offB1 = (unsigned)(r1 * ldb + c1);
  }
#define OFFSEL0_lda offA0
#define OFFSEL1_lda offA1
#define OFFSEL0_ldb offB0
#define OFFSEL1_ldb offB1
#define STAGE8(P, BASE, ld, hrow, kt)                                                                                         \
  do {                                                                                                                        \
    const bf16_t* _gb = (BASE) + (size_t)(hrow) * (ld) + (kt) * 64;                                                           \
    __builtin_amdgcn_global_load_lds((const unsigned*)(_gb + OFFSEL0_##ld), (unsigned*)((P) + tid * 16), 16, 0, 0);          \
    __builtin_amdgcn_global_load_lds((const unsigned*)(_gb + OFFSEL1_##ld), (unsigned*)((P) + tid * 16 + 8192), 16, 0, 0);   \
  } while (0)
#define LDA8(dst, b, h)                                                                                                       \
  _Pragma("unroll") for (int m = 0; m < 4; ++m) _Pragma("unroll") for (int k = 0; k < 2; ++k)                                  \
      dst[m][k] = *(const bf16x8*)(SA8(b, h) + lds_byte(wr * 64 + m * 16 + fr, k * 32 + fq * 8))
#define LDB8(dst, b, h)                                                                                                       \
  _Pragma("unroll") for (int n = 0; n < 2; ++n) _Pragma("unroll") for (int k = 0; k < 2; ++k)                                  \
      dst[n][k] = *(const bf16x8*)(SB8(b, h) + lds_byte(wc * 32 + n * 16 + fr, k * 32 + fq * 8))
#define MMA8(ai, bj, At_, Bt_)                                                                                                \
  do {                                                                                                                        \
    if (!GATED || active) {                                                                                                   \
      __builtin_amdgcn_s_setprio(1);                                                                                          \
      _Pragma("unroll") for (int m = 0; m < 4; ++m) _Pragma("unroll") for (int n = 0; n < 2; ++n) _Pragma("unroll") for (int k = 0; k < 2; ++k) \
          acc[(ai) * 4 + m][(bj) * 2 + n] = TRANS ? MFMA16(Bt_[n][k], At_[m][k], acc[(ai) * 4 + m][(bj) * 2 + n])             \
                                                  : MFMA16(At_[m][k], Bt_[n][k], acc[(ai) * 4 + m][(bj) * 2 + n]);             \
      __builtin_amdgcn_s_setprio(0);                                                                                          \
    }                                                                                                                         \
  } while (0)
#define WAITV8(n) asm volatile("s_waitcnt vmcnt(" #n ")" ::: "memory")
#define WAITL8(n) asm volatile("s_waitcnt lgkmcnt(" #n ")" ::: "memory")
#define BAR8 __builtin_amdgcn_s_barrier()
#define SCHED8 __builtin_amdgcn_sched_barrier(0)
#pragma unroll
  for (int m = 0; m < 8; ++m)
#pragma unroll
    for (int n = 0; n < 4; ++n) acc[m][n] = f32x4{0.f, 0.f, 0.f, 0.f};
  bf16x8 At[4][2], B0[2][2], B1[2][2];
  asm volatile("s_waitcnt vmcnt(0) lgkmcnt(0)" ::: "memory");
  BAR8;
  STAGE8(SB8(0, 0), Bt, ldb, 0, 0); STAGE8(SA8(0, 0), A, lda, 0, 0);
  STAGE8(SB8(0, 1), Bt, ldb, 128, 0); STAGE8(SA8(0, 1), A, lda, 128, 0);
  if (wr == 1) BAR8;
  WAITV8(4); BAR8;
  STAGE8(SB8(1, 0), Bt, ldb, 0, 1); STAGE8(SA8(1, 0), A, lda, 0, 1); STAGE8(SB8(1, 1), Bt, ldb, 128, 1);
  WAITV8(6); BAR8;
  for (int t = 0; t < nt - 2; t += 2) {
    LDB8(B0, 0, 0); SCHED8; LDA8(At, 0, 0); STAGE8(SA8(1, 1), A, lda, 128, t + 1);
    WAITL8(8); BAR8; WAITL8(0); MMA8(0, 0, At, B0); BAR8; SCHED8;
    LDB8(B1, 0, 1); STAGE8(SB8(0, 0), Bt, ldb, 0, t + 2);
    BAR8; WAITL8(0); MMA8(0, 1, At, B1); BAR8;
    LDA8(At, 0, 1); STAGE8(SA8(0, 0), A, lda, 0, t + 2);
    BAR8; WAITL8(0); MMA8(1, 0, At, B0); BAR8; SCHED8;
    STAGE8(SB8(0, 1), Bt, ldb, 128, t + 2);
    WAITV8(6); BAR8; MMA8(1, 1, At, B1); BAR8;
    LDB8(B0, 1, 0); SCHED8; LDA8(At, 1, 0); STAGE8(SA8(0, 1), A, lda, 128, t + 2);
    WAITL8(8); BAR8; WAITL8(0); MMA8(0, 0, At, B0); BAR8; SCHED8;
    LDB8(B1, 1, 1); STAGE8(SB8(1, 0), Bt, ldb, 0, t + 3);
    BAR8; WAITL8(0); MMA8(0, 1, At, B1); BAR8;
    LDA8(At, 1, 1); STAGE8(SA8(1, 0), A, lda, 0, t + 3);
    BAR8; WAITL8(0); MMA8(1, 0, At, B0); BAR8; SCHED8;
    STAGE8(SB8(1, 1), Bt, ldb, 128, t + 3);
    WAITV8(6); BAR8; MMA8(1, 1, At, B1); BAR8;
  }
  {
    LDB8(B0, 0, 0); LDA8(At, 0, 0); STAGE8(SA8(1, 1), A, lda, 128, nt - 1);
    BAR8; WAITL8(0); MMA8(0, 0, At, B0); BAR8;
    LDB8(B1, 0, 1); BAR8; WAITL8(0); MMA8(0, 1, At, B1); BAR8;
    LDA8(At, 0, 1); WAITV8(4); BAR8; WAITL8(0); MMA8(1, 0, At, B0); MMA8(1, 1, At, B1); BAR8;
  }
  {
    LDB8(B0, 1, 0); LDA8(At, 1, 0); WAITV8(2); BAR8; WAITL8(0); MMA8(0, 0, At, B0); BAR8;
    LDB8(B1, 1, 1); WAITV8(0); BAR8; WAITL8(0); MMA8(0, 1, At, B1); BAR8;
    LDA8(At, 1, 1); BAR8; WAITL8(0); MMA8(1, 0, At, B0); MMA8(1, 1, At, B1); BAR8;
  }
  if (wr == 0) BAR8;
}

DI void unit_order(int L, int nM, int nN, int& pm, int& pn) {
  const int nwg = nM * nN;
  int wgid = L;
  { const int q = nwg / 8, r = nwg % 8, xcd = wgid % 8, off = wgid / 8; wgid = (xcd < r ? xcd * (q + 1) : r * (q + 1) + (xcd - r) * q) + off; }
  const int nig = 8 * nN, gid = wgid / nig, fm = gid * 8, gsz = (nM - fm) < 8 ? (nM - fm) : 8;
  pm = fm + ((wgid % nig) % gsz);
  pn = (wgid % nig) / gsz;
}

DI void epi_proj(const Params& p, int pm, int pn, f32x4 (&acc)[8][4]) {
  const int tid = otid(p.wv);
  const int wid = tid >> 6, lane = tid & 63, wr = wid >> 2, wc = wid & 3, fr = lane & 15, fq = lane >> 4;
  const int brow = pm * 256;
  const int b = brow >> 11;
  const int srow0 = (brow & 2047) + fq * 4;
  const int trow0 = brow + fq * 4;
  const float2* t128 = (const float2*)(p.ws + OFF_MISC + MISC_TAB128);
  const float2* t64 = (const float2*)(p.ws + OFF_MISC + MISC_TAB64);
  if (pn < 4) {
    bf16_t* qa = (bf16_t*)(p.ws + OFF_QA);
    const int head = pn * 2 + (wc >> 1), w = wc & 1;
    const float sc = 0.08838834764831845f * LOG2E;
#pragma unroll
    for (int mb = 0; mb < 8; mb += 4) {
      float2 csb[4][4][2];
#pragma unroll
      for (int mi = 0; mi < 4; ++mi) {
        const int m = mb + mi;
#pragma unroll
      for (int j = 0; j < 4; ++j)
#pragma unroll
        for (int n = 0; n < 2; ++n) csb[mi][j][n] = t128[(srow0 + ROWM(m) + j) * 64 + 32 * w + 16 * n + fr];
      }
#pragma unroll
      for (int mi = 0; mi < 4; ++mi) {
        const int m = mb + mi;
        float2 (&cs)[4][2] = csb[mi];
#pragma unroll
      for (int j = 0; j < 4; ++j) {
        size_t tk = (size_t)(trow0 + ROWM(m) + j);
#pragma unroll
        for (int n = 0; n < 2; ++n) {
          int d1 = 32 * w + 16 * n + fr;
          float x1 = acc[m][n][j], x2 = acc[m][n + 2][j];
          qa[tk * 1024 + head * 128 + d1] = f2bf((x1 * cs[j][n].x - x2 * cs[j][n].y) * sc);
          qa[tk * 1024 + head * 128 + d1 + 64] = f2bf((x2 * cs[j][n].x + x1 * cs[j][n].y) * sc);
        }
      }
      }
    }
  } else if (pn == 4 || pn == 6 || pn == 8) {
    bf16_t* kd = (bf16_t*)(p.ws + (pn == 4 ? OFF_KCA : (pn == 6 ? OFF_KSA : OFF_KWA)));
    const int h = wc >> 1, w = wc & 1;
#pragma unroll
    for (int mb = 0; mb < 8; mb += 4) {
      float2 csb[4][4][2];
#pragma unroll
      for (int mi = 0; mi < 4; ++mi) {
        const int m = mb + mi;
#pragma unroll
      for (int j = 0; j < 4; ++j)
#pragma unroll
        for (int n = 0; n < 2; ++n) csb[mi][j][n] = t128[(srow0 + ROWM(m) + j) * 64 + 32 * w + 16 * n + fr];
      }
#pragma unroll
      for (int mi = 0; mi < 4; ++mi) {
        const int m = mb + mi;
        float2 (&cs)[4][2] = csb[mi];
#pragma unroll
      for (int j = 0; j < 4; ++j) {
        int s = srow0 + ROWM(m) + j;
        size_t rb = ((size_t)(b * 2 + h) * 2048 + s) * 128;
#pragma unroll
        for (int n = 0; n < 2; ++n) {
          int d1 = 32 * w + 16 * n + fr;
          float x1 = acc[m][n][j], x2 = acc[m][n + 2][j];
          kd[rb + d1] = f2bf(x1 * cs[j][n].x - x2 * cs[j][n].y);
          kd[rb + d1 + 64] = f2bf(x2 * cs[j][n].x + x1 * cs[j][n].y);
        }
      }
      }
    }
  } else if (pn == 5) {
    bf16_t* vd = (bf16_t*)(p.ws + OFF_VCA);
    const int h = wc >> 1, w = wc & 1;
#pragma unroll
    for (int m = 0; m < 8; ++m)
#pragma unroll
      for (int j = 0; j < 4; ++j) {
        int s = srow0 + ROWM(m) + j;
        size_t rb = ((size_t)(b * 2 + h) * 2048 + s) * 128;
#pragma unroll
        for (int n = 0; n < 4; ++n) vd[rb + w * 64 + n * 16 + fr] = f2bf(acc[m][n][j]);
      }
  } else if (pn == 7 || pn == 9) {
    bf16_t* vd = (bf16_t*)(p.ws + (pn == 7 ? OFF_VSAT : OFF_VWAT));
    const int h = wc >> 1, w = wc & 1;
#pragma unroll
    for (int m = 0; m < 8; ++m) {
      int s0 = srow0 + ROWM(m);
#pragma unroll
      for (int n = 0; n < 4; ++n) {
        int d = w * 64 + n * 16 + fr;
        uint2 o;
        o.x = pack2(acc[m][n][0], acc[m][n][1]);
        o.y = pack2(acc[m][n][2], acc[m][n][3]);
        *(uint2*)(vd + ((size_t)(b * 2 + h) * 128 + d) * 2048 + s0) = o;
      }
    }
  } else if ((pn >= 10 && pn < 14) || (pn >= 19 && pn < 23)) {
    bf16_t* zd = (bf16_t*)(p.ws + (pn < 14 ? OFF_ZA : OFF_ZB));
    const int cb = (pn < 14 ? (pn - 10) : (pn - 19)) * 256 + wc * 64;
#pragma unroll
    for (int m = 0; m < 8; ++m)
#pragma unroll
      for (int j = 0; j < 4; ++j) {
        size_t tk = (size_t)(trow0 + ROWM(m) + j);
#pragma unroll
        for (int n = 0; n < 4; ++n) zd[tk * 1024 + cb + n * 16 + fr] = f2bf(silu_f(acc[m][n][j]));
      }
  } else if (pn >= 14 && pn < 18) {
    bf16_t* qb = (bf16_t*)(p.ws + OFF_QB);
    const int head = (pn - 14) * 4 + wc;
    const float sc = 0.125f * LOG2E;
#pragma unroll
    for (int mb = 0; mb < 8; mb += 4) {
      float2 csb[4][4][2];
#pragma unroll
      for (int mi = 0; mi < 4; ++mi) {
        const int m = mb + mi;
#pragma unroll
      for (int j = 0; j < 4; ++j)
#pragma unroll
        for (int n = 0; n < 2; ++n) csb[mi][j][n] = t64[(srow0 + ROWM(m) + j) * 32 + 16 * n + fr];
      }
#pragma unroll
      for (int mi = 0; mi < 4; ++mi) {
        const int m = mb + mi;
        float2 (&cs)[4][2] = csb[mi];
#pragma unroll
      for (int j = 0; j < 4; ++j) {
        size_t tk = (size_t)(trow0 + ROWM(m) + j);
#pragma unroll
        for (int n = 0; n < 2; ++n) {
          int d1 = 16 * n + fr;
          float x1 = acc[m][n][j], x2 = acc[m][n + 2][j];
          qb[tk * 1024 + head * 64 + d1] = f2bf((x1 * cs[j][n].x - x2 * cs[j][n].y) * sc);
          qb[tk * 1024 + head * 64 + d1 + 32] = f2bf((x2 * cs[j][n].x + x1 * cs[j][n].y) * sc);
        }
      }
      }
    }
  } else if (pn == 18) {
    if (wc < 2) {
      bf16_t* kd = (bf16_t*)(p.ws + OFF_KB);
      const int h = wc;
#pragma unroll
      for (int mb = 0; mb < 8; mb += 4) {
        float2 csb[4][4][2];
#pragma unroll
        for (int mi = 0; mi < 4; ++mi) {
          const int m = mb + mi;
#pragma unroll
        for (int j = 0; j < 4; ++j)
#pragma unroll
          for (int n = 0; n < 2; ++n) csb[mi][j][n] = t64[(srow0 + ROWM(m) + j) * 32 + 16 * n + fr];
        }
#pragma unroll
        for (int mi = 0; mi < 4; ++mi) {
          const int m = mb + mi;
          float2 (&cs)[4][2] = csb[mi];
#pragma unroll
        for (int j = 0; j < 4; ++j) {
          int s = srow0 + ROWM(m) + j;
          size_t rb = ((size_t)(b * 2 + h) * 2048 + s) * 64;
#pragma unroll
          for (int n = 0; n < 2; ++n) {
            int d1 = 16 * n + fr;
            float x1 = acc[m][n][j], x2 = acc[m][n + 2][j];
            kd[rb + d1] = f2bf(x1 * cs[j][n].x - x2 * cs[j][n].y);
            kd[rb + d1 + 32] = f2bf(x2 * cs[j][n].x + x1 * cs[j][n].y);
          }
        }
        }
      }
    } else {
      bf16_t* vd = (bf16_t*)(p.ws + OFF_VBT);
      const int h = wc - 2;
#pragma unroll
      for (int m = 0; m < 8; ++m) {
        int s0 = srow0 + ROWM(m);
#pragma unroll
        for (int n = 0; n < 4; ++n) {
          int d = n * 16 + fr;
          uint2 o;
          o.x = pack2(acc[m][n][0], acc[m][n][1]);
          o.y = pack2(acc[m][n][2], acc[m][n][3]);
          *(uint2*)(vd + ((size_t)(b * 2 + h) * 64 + d) * 2048 + s0) = o;
        }
      }
    }
  } else {
    if (wc == 0) {
      float* gd = (float*)(p.ws + OFF_GATES);
#pragma unroll
      for (int m = 0; m < 8; ++m)
#pragma unroll
        for (int j = 0; j < 4; ++j) {
          size_t tk = (size_t)(trow0 + ROWM(m) + j);
#pragma unroll
          for (int n = 0; n < 2; ++n) {
            int c = n * 16 + fr;
            if (c < 24) gd[tk * 24 + c] = sigmoid_f(acc[m][n][j]);
          }
        }
    }
  }
}

DI void phase_proj(const Params& p) {
  const bf16_t* hb = (const bf16_t*)(p.ws + OFF_HB);
  const bf16_t* wtin = (const bf16_t*)(p.ws + OFF_WTIN);
  for (int L = blockIdx.x; L < 64 * 24; L += gridDim.x) {
    int pm, pn;
    unit_order(L, 64, 24, pm, pn);
    f32x4 acc[8][4];
    if (pn == 23) gemm_mainloop8<false, true>(p.wv, hb + (size_t)pm * 256 * DM, DM, wtin + (size_t)pn * 256 * DM, DM, DM / 64, acc, (p.wv & 3) == 0);
    else gemm_mainloop8<false, false>(p.wv, hb + (size_t)pm * 256 * DM, DM, wtin + (size_t)pn * 256 * DM, DM, DM / 64, acc);
    epi_proj(p, pm, pn, acc);
  }
}

template <int ROWS, int D>
DI void load_rows_tile(const bf16_t* __restrict__ src, char* dst, int tid) {
  constexpr int KSTR = D * 2 + 16, CH = D / 8, NI = ROWS * CH / NTHR;
  u32x4 v[NI];
#pragma unroll
  for (int i = 0; i < NI; ++i) v[i] = *(const u32x4*)(src + (tid + i * NTHR) * 8);
#pragma unroll
  for (int i = 0; i < NI; ++i) {
    const int idx = tid + i * NTHR;
    *(u32x4*)(dst + (idx / CH) * KSTR + (idx % CH) * 16) = v[i];
  }
}
template <int D, int NKEY>
DI void load_vt_tile(const bf16_t* __restrict__ srcT, int gstride, char* dst, int tid) {
  constexpr int VSTR = NKEY * 2 + 8, CH = NKEY / 8, NI = D * CH / NTHR;
  u32x4 v[NI];
#pragma unroll
  for (int i = 0; i < NI; ++i) {
    const int idx = tid + i * NTHR;
    v[i] = *(const u32x4*)(srcT + (size_t)(idx / CH) * gstride + (idx % CH) * 8);
  }
#pragma unroll
  for (int i = 0; i < NI; ++i) {
    const int idx = tid + i * NTHR;
    uint2* q = (uint2*)(dst + (idx / CH) * VSTR + (idx % CH) * 16);
    q[0] = make_uint2(v[i][0], v[i][1]);
    q[1] = make_uint2(v[i][2], v[i][3]);
  }
}
DI bf16x8 pack8(const f32x16& x, int s) {
  union { unsigned u[4]; bf16x8 v; } t;
#pragma unroll
  for (int q = 0; q < 4; ++q) t.u[q] = pack2(x[8 * s + 2 * q], x[8 * s + 2 * q + 1]);
  return t.v;
}
DI bf16x8 lds_vfrag(const char* pv) {
  union { uint2 u[2]; bf16x8 v; } t;
  t.u[0] = *(const uint2*)(pv);
  t.u[1] = *(const uint2*)(pv + 16);
  return t.v;
}

template <int D, class VF>
DI void attn_subtile(const char* Ks, const char* Vt, int vstr, const bf16x8* Qf, f32x16* O, float& m, float& l, int r, int hh, VF valid) {
  constexpr int KSTR = D * 2 + 16;
  f32x16 S;
#pragma unroll
  for (int i = 0; i < 16; ++i) S[i] = 0.f;
#pragma unroll
  for (int ks = 0; ks < D / 16; ++ks) {
    bf16x8 kf = *(const bf16x8*)(Ks + r * KSTR + (ks * 16 + hh * 8) * 2);
    S = MFMA32(kf, Qf[ks], S);
  }
  float mx = -1e30f;
#pragma unroll
  for (int i = 0; i < 16; ++i) {
    bool ok = valid(crow(i, hh));
    S[i] = ok ? S[i] : -1e30f;
    mx = fmaxf(mx, S[i]);
  }
  mx = fmaxf(mx, __shfl_xor(mx, 32));
  float mnew = fmaxf(m, mx);
  float alpha = ex2(m - mnew);
  float ps = 0.f;
#pragma unroll
  for (int i = 0; i < 16; ++i) {
    float pv = (S[i] > -1e29f) ? ex2(S[i] - mnew) : 0.f;
    ps += pv;
    S[i] = pv;
  }
  ps += __shfl_xor(ps, 32);
  l = l * alpha + ps;
  m = mnew;
#pragma unroll
  for (int dt = 0; dt < D / 32; ++dt)
#pragma unroll
    for (int i = 0; i < 16; ++i) O[dt][i] *= alpha;
  bf16x8 pf0 = pack8(S, 0), pf1 = pack8(S, 1);
#pragma unroll
  for (int dt = 0; dt < D / 32; ++dt) {
    const char* vrow = Vt + (dt * 32 + r) * vstr + hh * 8;
    bf16x8 v0 = lds_vfrag(vrow);
    bf16x8 v1 = lds_vfrag(vrow + 32);
    O[dt] = MFMA32(v0, pf0, O[dt]);
    O[dt] = MFMA32(v1, pf1, O[dt]);
  }
}

struct PFrag { bf16x8 a0, a1, b0, b1; };
template <int D, class VF>
DI void attn_scores(const char* Ks, const bf16x8* Qf, f32x16* O, float& m, float& l, int r, int hh, bool colsel, bool masked,
                    bool first, VF valid, PFrag& P) {
  constexpr int KSTR = D * 2 + 16;
  f32x16 S0, S1;
#pragma unroll
  for (int i = 0; i < 16; ++i) { S0[i] = 0.f; S1[i] = 0.f; }
  __builtin_amdgcn_s_setprio(1);
#pragma unroll
  for (int ks = 0; ks < D / 16; ++ks) {
    bf16x8 k0 = *(const bf16x8*)(Ks + r * KSTR + (ks * 16 + hh * 8) * 2);
    bf16x8 k1 = *(const bf16x8*)(Ks + (32 + r) * KSTR + (ks * 16 + hh * 8) * 2);
    S0 = MFMA32(k0, Qf[ks], S0);
    S1 = MFMA32(k1, Qf[ks], S1);
  }
  __builtin_amdgcn_s_setprio(0);
  if (masked) {
#pragma unroll
    for (int i = 0; i < 16; ++i) {
      S0[i] = valid(crow(i, hh)) ? S0[i] : -1e30f;
      S1[i] = valid(32 + crow(i, hh)) ? S1[i] : -1e30f;
    }
  }
  if (first || __builtin_amdgcn_ballot_w64(m < -1e29f) != 0ull) {
    float mx = -1e30f;
#pragma unroll
    for (int i = 0; i < 16; ++i) mx = fmaxf(mx, fmaxf(S0[i], S1[i]));
    if (!colsel) mx = -1e30f;
    mx = fmaxf(mx, xhalf(mx, r, hh));
    if (first || m < -1e29f) {
      const float mnew = fmaxf(m, mx);
      l *= ex2(m - mnew);
      m = mnew;
    }
  }
  const float moff = (colsel && m > -1e29f) ? m : 1e30f;
  float ps = 0.f;
#pragma unroll
  for (int i = 0; i < 16; ++i) {
    float p0 = ex2(S0[i] - moff), p1 = ex2(S1[i] - moff);
    ps += p0 + p1;
    S0[i] = p0;
    S1[i] = p1;
  }
  if (__builtin_amdgcn_ballot_w64(ps > 4096.f) != 0ull) {
    const float ps2 = ps + xhalf(ps, r, hh);
    const int e = ps2 > 4096.f ? (int)((__float_as_uint(ps2) >> 23) & 0xffu) - 127 : 0;
    const float sc = __uint_as_float((unsigned)(127 - e) << 23);
    m += (float)e;
    l *= sc;
    ps *= sc;
#pragma unroll
    for (int i = 0; i < 16; ++i) { S0[i] *= sc; S1[i] *= sc; }
#pragma unroll
    for (int dt = 0; dt < D / 32; ++dt)
#pragma unroll
      for (int i = 0; i < 16; ++i) O[dt][i] *= sc;
  }
  l += ps;
  P.a0 = pack8(S0, 0);
  P.a1 = pack8(S0, 1);
  P.b0 = pack8(S1, 0);
  P.b1 = pack8(S1, 1);
}

template <int D>
DI void attn_pv(const char* Vs, f32x16* O, const PFrag& P, int r, int hh) {
  __builtin_amdgcn_s_setprio(1);
#pragma unroll
  for (int dt = 0; dt < D / 32; ++dt) {
    const char* vrow = Vs + (dt * 32 + r) * 144 + hh * 16;
    bf16x8 v0 = *(const bf16x8*)(vrow);
    bf16x8 v1 = *(const bf16x8*)(vrow + 32);
    bf16x8 v2 = *(const bf16x8*)(vrow + 64);
    bf16x8 v3 = *(const bf16x8*)(vrow + 96);
    O[dt] = MFMA32(v0, P.a0, O[dt]);
    O[dt] = MFMA32(v1, P.a1, O[dt]);
    O[dt] = MFMA32(v2, P.b0, O[dt]);
    O[dt] = MFMA32(v3, P.b1, O[dt]);
  }
  __builtin_amdgcn_s_setprio(0);
}

DI void wave_lds_fence() {
  __builtin_amdgcn_fence(__ATOMIC_RELEASE, "wavefront");
  __builtin_amdgcn_wave_barrier();
  __builtin_amdgcn_fence(__ATOMIC_ACQUIRE, "wavefront");
}
template <int G, int ROWB, int NT>
DI void wtile_load(const bf16_t* __restrict__ g0, size_t tstride, char* lw, int lane) {
  u32x4 v[NT];
#pragma unroll
  for (int i = 0; i < NT; ++i) v[i] = __builtin_nontemporal_load((const u32x4*)(g0 + (size_t)i * tstride + lane * 8));
  wave_lds_fence();
#pragma unroll
  for (int i = 0; i < NT; ++i) {
    uint2* q = (uint2*)(lw + (i * G + (lane * 16) / ROWB) * (ROWB + 8) + (lane * 16) % ROWB);
    q[0] = make_uint2(v[i][0], v[i][1]);
    q[1] = make_uint2(v[i][2], v[i][3]);
  }
  wave_lds_fence();
}
template <int G, int ROWB, int NT>
DI void wtile_store(bf16_t* __restrict__ g0, size_t tstride, const char* lw, int lane) {
  wave_lds_fence();
#pragma unroll
  for (int i = 0; i < NT; ++i) {
    const uint2* q = (const uint2*)(lw + (i * G + (lane * 16) / ROWB) * (ROWB + 8) + (lane * 16) % ROWB);
    uint2 a = q[0], b2 = q[1];
    u32x4 v = {a.x, a.y, b2.x, b2.y};
    *(u32x4*)(g0 + (size_t)i * tstride + lane * 8) = v;
  }
}

template <int D>
struct KVPrefetch {
  static constexpr int NC = (64 * D / 8) / NTHR;
  u32x4 k0, k1, v0, v1;
  DI void issue(const bf16_t* __restrict__ ksrc, const bf16_t* __restrict__ vsrcT, int tid) {
    k0 = *(const u32x4*)(ksrc + tid * 8);
    v0 = *(const u32x4*)(vsrcT + (size_t)(tid >> 3) * 2048 + (tid & 7) * 8);
    if constexpr (NC > 1) {
      const int idx = tid + NTHR;
      k1 = *(const u32x4*)(ksrc + idx * 8);
      v1 = *(const u32x4*)(vsrcT + (size_t)(idx >> 3) * 2048 + (idx & 7) * 8);
    }
  }
  DI void commit(char* Ks, char* Vs, int tid) {
    constexpr int KSTR = D * 2 + 16, CH = D / 8;
    {
      *(u32x4*)(Ks + (tid / CH) * KSTR + (tid % CH) * 16) = k0;
      char* q = Vs + (tid >> 3) * 144 + ((tid & 7) >> 1) * 32 + (tid & 1) * 8;
      *(uint2*)q = make_uint2(v0.x, v0.y);
      *(uint2*)(q + 16) = make_uint2(v0.z, v0.w);
    }
    if constexpr (NC > 1) {
      const int idx = tid + NTHR;
      *(u32x4*)(Ks + (idx / CH) * KSTR + (idx % CH) * 16) = k1;
      char* q = Vs + (idx >> 3) * 144 + ((idx & 7) >> 1) * 32 + (idx & 1) * 8;
      *(uint2*)q = make_uint2(v1.x, v1.y);
      *(uint2*)(q + 16) = make_uint2(v1.z, v1.w);
    }
  }
};

DI int next_item(int wv, int* ctr) {
  int* sl = (int*)(g_shm + SHM_BYTES - 16);
  __syncthreads();
  if (otid(wv) == 0) *sl = atomicAdd(ctr, 1);
  __syncthreads();
  int v = *sl;
  return v;
}

DI void item_compress_part(const Params& p, int mat, int mt, int ks) {
  const bf16_t* A = (const bf16_t*)(p.ws + (mat ? OFF_VCA : OFF_KCA)) + (size_t)mt * 256 * 2048 + ks * 1024;
  const bf16_t* w1t = (const bf16_t*)(p.ws + OFF_W1T) + (size_t)mat * 256 * 4096 + ks * 1024;
  f32x4 acc[8][4];
  gemm_mainloop8<false>(p.wv, A, 2048, w1t, 4096, 1024 / 64, acc);
  const int tid = otid(p.wv), wid = tid >> 6, lane = tid & 63, wr = wid >> 2, wc = wid & 3, fr = lane & 15, fq = lane >> 4;
  float* part = (float*)(p.ws + OFF_CPART) + ((size_t)(mat * 4 + ks) * 2048 + mt * 256) * 256;
#pragma unroll
  for (int m = 0; m < 8; ++m)
#pragma unroll
    for (int n = 0; n < 4; ++n)
#pragma unroll
      for (int j = 0; j < 4; ++j) part[(size_t)(ROWM(m) + fq * 4 + j) * 256 + COLN(n) + fr] = acc[m][n][j];
  asm volatile("s_waitcnt vmcnt(0)" ::: "memory");
  __syncthreads();
  if (tid == 0) {
    __builtin_amdgcn_fence(__ATOMIC_RELEASE, "agent");
    asm volatile("s_waitcnt vmcnt(0)" ::: "memory");
    __hip_atomic_fetch_add((unsigned*)(p.ws + OFF_MISC + MISC_CTR) + 256 + mat * 8 + mt, 1u, __ATOMIC_RELAXED, __HIP_MEMORY_SCOPE_AGENT);
  }
}

DI void item_compress_fin(const Params& p, int mat, int rb) {
  const int tid = otid(p.wv), wid = tid >> 6, lane = tid & 63;
  const bf16_t* w2t = (const bf16_t*)(p.ws + OFF_W2T) + (size_t)mat * 128 * 256;
  const float* biasp = (const float*)(p.ws + OFF_MISC + MISC_BIASP) + mat * 16 * 256;
  const float* part = (const float*)(p.ws + OFF_CPART) + (size_t)(mat * 4) * 2048 * 256;
  constexpr int HSTR = 528;
  const int R0 = rb * 64;
  __syncthreads();
  {
    const int c4 = (tid & 63) * 4, rq = tid >> 6;
    f32x4 bias = {0.f, 0.f, 0.f, 0.f};
#pragma unroll
    for (int ch = 0; ch < 16; ++ch) bias += *(const f32x4*)(biasp + ch * 256 + c4);
#pragma unroll
    for (int i = 0; i < 8; ++i) {
      const int row = rq + 8 * i;
      f32x4 a = bias;
#pragma unroll
      for (int ks = 0; ks < 4; ++ks) a += *(const f32x4*)(part + ((size_t)ks * 2048 + R0 + row) * 256 + c4);
      uint2 o;
      o.x = pack2(silu_f(a[0]), silu_f(a[1]));
      o.y = pack2(silu_f(a[2]), silu_f(a[3]));
      *(uint2*)(g_shm + row * HSTR + c4 * 2) = o;
    }
  }
  __syncthreads();
  {
    const int r = lane & 31, hh = lane >> 5;
    const int rh = wid & 1, ct = wid >> 1;
    f32x16 C;
#pragma unroll
    for (int i = 0; i < 16; ++i) C[i] = 0.f;
#pragma unroll 4
    for (int ks = 0; ks < 16; ++ks) {
      bf16x8 hf = *(const bf16x8*)(g_shm + (rh * 32 + r) * HSTR + (ks * 16 + hh * 8) * 2);
      bf16x8 wf = *(const bf16x8*)(w2t + (size_t)(ct * 32 + r) * 256 + ks * 16 + hh * 8);
      if (mat == 0) C = MFMA32(wf, hf, C);
      else C = MFMA32(hf, wf, C);
    }
    if (mat == 0) {
      bf16_t* kc = (bf16_t*)(p.ws + OFF_KC);
      size_t R = (size_t)R0 + rh * 32 + r;
#pragma unroll
      for (int g = 0; g < 4; ++g) {
        uint2 o;
        o.x = pack2(C[4 * g], C[4 * g + 1]);
        o.y = pack2(C[4 * g + 2], C[4 * g + 3]);
        *(uint2*)(kc + R * 128 + ct * 32 + 8 * g + 4 * hh) = o;
      }
    } else {
      bf16_t* vct = (bf16_t*)(p.ws + OFF_VCT);
#pragma unroll
      for (int g = 0; g < 4; ++g) {
        int Rr = R0 + rh * 32 + 8 * g + 4 * hh;
        int bh = Rr >> 7, c0 = Rr & 127;
        uint2 o;
        o.x = pack2(C[4 * g], C[4 * g + 1]);
        o.y = pack2(C[4 * g + 2], C[4 * g + 3]);
        *(uint2*)(vct + ((size_t)bh * 128 + ct * 32 + r) * 128 + c0) = o;
      }
    }
  }
}

DI void phase_cmp2(const Params& p) {
  for (int it = blockIdx.x; it < 64; it += gridDim.x) item_compress_fin(p, it >> 5, it & 31);
}

DI void item_win_a(const Params& p, int b, int h, int qb) {
  const int tid = otid(p.wv);
  const int wid = tid >> 6, lane = tid & 63, r = lane & 31, hh = lane >> 5;
  const int q0 = qb * 64;
  const int t = q0 + wid * 8 + (r >> 2);
  const int head = h * 4 + (r & 3);
  const bf16_t* qa = (const bf16_t*)(p.ws + OFF_QA) + ((size_t)(b * 2048 + t) * 1024 + head * 128);
  const bf16_t* kw = (const bf16_t*)(p.ws + OFF_KWA) + (size_t)(b * 2 + h) * 2048 * 128;
  const bf16_t* vt = (const bf16_t*)(p.ws + OFF_VWAT) + (size_t)(b * 2 + h) * 128 * 2048;
  bf16x8 Qf[8];
#pragma unroll
  for (int ks = 0; ks < 8; ++ks) Qf[ks] = *(const bf16x8*)(qa + ks * 16 + hh * 8);
  f32x16 O[4];
#pragma unroll
  for (int dt = 0; dt < 4; ++dt)
#pragma unroll
    for (int i = 0; i < 16; ++i) O[dt][i] = 0.f;
  float m = -1e30f, l = 0.f;
  const int tw0 = q0 + wid * 8, tw1 = tw0 + 7;
  int kt0 = qb - 8 < 0 ? 0 : qb - 8;
  {
    KVPrefetch<128> pf;
    pf.issue(kw + (size_t)kt0 * 64 * 128, vt + kt0 * 64, tid);
    __syncthreads();
    pf.commit(g_shm, g_shm + 34816, tid);
    if (kt0 + 1 <= qb) pf.issue(kw + (size_t)(kt0 + 1) * 64 * 128, vt + (kt0 + 1) * 64, tid);
    __syncthreads();
    const bool late = p.wv >= 4;
    PFrag Pc;
    bool have = false;
    int vprev = 0;
    for (int kt = kt0; kt <= qb; ++kt) {
      const int j = kt - kt0, cur = j & 1, vc = j % 3;
      if (late && have) { attn_pv<128>(g_shm + 34816 + vprev * 18432, O, Pc, r, hh); have = false; }
      {
        const int key0 = kt * 64;
        if (key0 <= tw1 && key0 + 63 > tw0 - 512) {
          auto vf = [&](int kl) { int key = key0 + kl; return key <= t && t - key < 512; };
          const bool masked = !(key0 + 63 <= tw0 && tw1 - key0 < 512);
          PFrag Pn;
          attn_scores<128>(g_shm + cur * 17408, Qf, O, m, l, r, hh, true, masked, kt == kt0, vf, Pn);
          if (late) { Pc = Pn; have = true; vprev = vc; }
          else attn_pv<128>(g_shm + 34816 + vc * 18432, O, Pn, r, hh);
        }
      }
      if (kt + 1 <= qb) {
        pf.commit(g_shm + (cur ^ 1) * 17408, g_shm + 34816 + ((vc + 1) % 3) * 18432, tid);
        if (kt + 2 <= qb) pf.issue(kw + (size_t)(kt + 2) * 64 * 128, vt + (kt + 2) * 64, tid);
      }
      __syncthreads();
    }
    if (late && have) attn_pv<128>(g_shm + 34816 + vprev * 18432, O, Pc, r, hh);
    __syncthreads();
  }
  l += xhalf(l, r, hh);
  float inv = 1.f / fmaxf(l, 1e-30f);
  char* lw = g_shm + wid * 8448;
#pragma unroll
  for (int dt = 0; dt < 4; ++dt)
#pragma unroll
    for (int g = 0; g < 4; ++g) {
      uint2 o;
      o.x = pack2(O[dt][4 * g] * inv, O[dt][4 * g + 1] * inv);
      o.y = pack2(O[dt][4 * g + 2] * inv, O[dt][4 * g + 3] * inv);
      *(uint2*)(lw + r * 264 + (dt * 32 + 8 * g + 4 * hh) * 2) = o;
    }
  wtile_store<4, 256, 8>((bf16_t*)(p.ws + OFF_OWIN) + (size_t)(b * 2048 + q0 + wid * 8) * 1024 + h * 512, 1024, lw, lane);
}

DI void item_attn_b(const Params& p, int b, int h, int qb) {
  const int tid = otid(p.wv);
  const int wid = tid >> 6, lane = tid & 63, r = lane & 31, hh = lane >> 5;
  const int q0 = qb * 32;
  const int t = q0 + wid * 4 + (r >> 3);
  const int head = h * 8 + (r & 7);
  const bf16_t* qp = (const bf16_t*)(p.ws + OFF_QB) + ((size_t)(b * 2048 + t) * 1024 + head * 64);
  const bf16_t* kb = (const bf16_t*)(p.ws + OFF_KB) + (size_t)(b * 2 + h) * 2048 * 64;
  const bf16_t* vt = (const bf16_t*)(p.ws + OFF_VBT) + (size_t)(b * 2 + h) * 64 * 2048;
  bf16x8 Qf[4];
#pragma unroll
  for (int ks = 0; ks < 4; ++ks) Qf[ks] = *(const bf16x8*)(qp + ks * 16 + hh * 8);
  f32x16 O[2];
#pragma unroll
  for (int dt = 0; dt < 2; ++dt)
#pragma unroll
    for (int i = 0; i < 16; ++i) O[dt][i] = 0.f;
  float m = p.sinks[head] * LOG2E, l = hh == 0 ? 1.f : 0.f;
  const int tw0 = q0 + wid * 4, tw1 = tw0 + 3;
  int kt0 = (q0 - 127) < 0 ? 0 : ((q0 - 127) >> 6);
  int kt1 = (q0 + 31) >> 6;
  {
    KVPrefetch<64> pf;
    pf.issue(kb + (size_t)kt0 * 64 * 64, vt + kt0 * 64, tid);
    __syncthreads();
    pf.commit(g_shm, g_shm + 34816, tid);
    if (kt0 + 1 <= kt1) pf.issue(kb + (size_t)(kt0 + 1) * 64 * 64, vt + (kt0 + 1) * 64, tid);
    __syncthreads();
    const bool late = p.wv >= 4;
    PFrag Pc;
    bool have = false;
    int vprev = 0;
    for (int kt = kt0; kt <= kt1; ++kt) {
      const int j = kt - kt0, cur = j & 1, vc = j % 3;
      if (late && have) { attn_pv<64>(g_shm + 34816 + vprev * 18432, O, Pc, r, hh); have = false; }
      {
        const int key0 = kt * 64;
        if (key0 <= tw1 && key0 + 63 > tw0 - 128) {
          auto vf = [&](int kl) { int key = key0 + kl; return key <= t && t - key < 128; };
          const bool masked = !(key0 + 63 <= tw0 && tw1 - key0 < 128);
          PFrag Pn;
          attn_scores<64>(g_shm + cur * 17408, Qf, O, m, l, r, hh, true, masked, kt == kt0, vf, Pn);
          if (late) { Pc = Pn; have = true; vprev = vc; }
          else attn_pv<64>(g_shm + 34816 + vc * 18432, O, Pn, r, hh);
        }
      }
      if (kt + 1 <= kt1) {
        pf.commit(g_shm + (cur ^ 1) * 17408, g_shm + 34816 + ((vc + 1) % 3) * 18432, tid);
        if (kt + 2 <= kt1) pf.issue(kb + (size_t)(kt + 2) * 64 * 64, vt + (kt + 2) * 64, tid);
      }
      __syncthreads();
    }
    if (late && have) attn_pv<64>(g_shm + 34816 + vprev * 18432, O, Pc, r, hh);
    __syncthreads();
  }
  l += xhalf(l, r, hh);
  float inv = 1.f / fmaxf(l, 1e-30f);
  char* lw = g_shm + wid * 4352;
  const size_t tok0 = (size_t)(b * 2048 + q0 + wid * 4);
  wtile_load<8, 128, 4>((const bf16_t*)(p.ws + OFF_ZB) + tok0 * 1024 + h * 512, 1024, lw, lane);
  uint2 zr[2][4];
#pragma unroll
  for (int dt = 0; dt < 2; ++dt)
#pragma unroll
    for (int g = 0; g < 4; ++g) zr[dt][g] = *(const uint2*)(lw + r * 136 + (dt * 32 + 8 * g + 4 * hh) * 2);
#pragma unroll
  for (int dt = 0; dt < 2; ++dt)
#pragma unroll
    for (int g = 0; g < 4; ++g) {
      uint2 z = zr[dt][g];
      float z0 = __uint_as_float(z.x << 16), z1 = __uint_as_float(z.x & 0xffff0000u), z2 = __uint_as_float(z.y << 16), z3 = __uint_as_float(z.y & 0xffff0000u);
      uint2 o;
      o.x = pack2(O[dt][4 * g] * inv * z0, O[dt][4 * g + 1] * inv * z1);
      o.y = pack2(O[dt][4 * g + 2] * inv * z2, O[dt][4 * g + 3] * inv * z3);
      *(uint2*)(lw + r * 136 + (dt * 32 + 8 * g + 4 * hh) * 2) = o;
    }
  wtile_store<8, 128, 4>((bf16_t*)(p.ws + OFF_Y) + tok0 * 2048 + 1024 + h * 512, 2048, lw, lane);
}

DI void phase_mix1(const Params& p) {
  int* ctr = (int*)(p.ws + OFF_MISC + MISC_CTR);
  constexpr int N_CMP = 64, N_WA = 8 * 2 * 32, N_FIN = 64, N_B = 8 * 2 * 64;
  int* sl = (int*)(g_shm + SHM_BYTES - 16);
  int it = next_item(p.wv, ctr);
  for (;;) {
    if (it >= N_CMP + N_WA + N_FIN + N_B) break;
    int nxt = 0;
    const bool leader = otid(p.wv) == 0;
    if (leader) nxt = atomicAdd(ctr, 1);
    if (it < N_CMP) item_compress_part(p, it >> 5, (it >> 2) & 7, it & 3);
    else if (it < N_CMP + N_WA) { int i2 = it - N_CMP; int qb = 31 - (i2 >> 4), bh = i2 & 15; item_win_a(p, bh >> 1, bh & 1, qb); }
    else if (it < N_CMP + N_WA + N_FIN) {
      const int i2 = it - N_CMP - N_WA, mat = i2 >> 5, rb = i2 & 31;
      if (leader) {
        unsigned* cd = (unsigned*)(p.ws + OFF_MISC + MISC_CTR) + 256 + mat * 8 + (rb >> 2);
        unsigned sp = 0;
        while (__hip_atomic_load(cd, __ATOMIC_RELAXED, __HIP_MEMORY_SCOPE_AGENT) < 4u) {
          __builtin_amdgcn_s_sleep(4);
          if (++sp > (1u << 22)) break;
        }
        __builtin_amdgcn_fence(__ATOMIC_ACQUIRE, "agent");
        asm volatile("s_waitcnt vmcnt(0)" ::: "memory");
      }
      __syncthreads();
      item_compress_fin(p, mat, rb);
    }
    else { int i2 = it - N_CMP - N_WA - N_FIN; int qb = i2 >> 4, bh = i2 & 15; item_attn_b(p, bh >> 1, bh & 1, qb); }
    __syncthreads();
    if (leader) *sl = nxt;
    __syncthreads();
    it = *sl;
  }
}

DI void item_nsa(const Params& p, int b, int h, int qb) {
  const int tid = otid(p.wv);
  const int wid = tid >> 6, lane = tid & 63, r = lane & 31, hh = lane >> 5;
  const int q0 = qb * 64;
  const int tokl = wid * 8 + (r >> 2);
  const int t = q0 + tokl;
  const int head = h * 4 + (r & 3);
  const bf16_t* qa = (const bf16_t*)(p.ws + OFF_QA) + ((size_t)(b * 2048 + t) * 1024 + head * 128);
  bf16x8 Qf[8];
#pragma unroll
  for (int ks = 0; ks < 8; ++ks) Qf[ks] = *(const bf16x8*)(qa + ks * 16 + hh * 8);
  char* KcL = g_shm;
  char* VcL = g_shm + 34816;
  float* psum = (float*)(g_shm + 68608);
  float* scs = (float*)(g_shm + 101632);
  unsigned* smask = (unsigned*)(g_shm + 110080);
  char* OcL = g_shm;
  KVPrefetch<128> pf;
  pf.issue((const bf16_t*)(p.ws + OFF_KSA) + (size_t)(b * 2 + h) * 2048 * 128, (const bf16_t*)(p.ws + OFF_VSAT) + (size_t)(b * 2 + h) * 128 * 2048, tid);
  __syncthreads();
  load_rows_tile<128, 128>((const bf16_t*)(p.ws + OFF_KC) + (size_t)(b * 2 + h) * 128 * 128, KcL, tid);
  load_vt_tile<128, 128>((const bf16_t*)(p.ws + OFF_VCT) + (size_t)(b * 2 + h) * 128 * 128, 128, VcL, tid);
  __syncthreads();
  f32x16 Oc[4];
  {
    f32x16 S[4];
    const int cmax = t >= 31 ? ((t - 31) >> 4) : -1;
    const int tlast = q0 + p.wv * 8 + 7;
    const int cmax_w = tlast >= 31 ? ((tlast - 31) >> 4) : -1;
    float mx = -1e30f;
#pragma unroll
    for (int sub = 0; sub < 4; ++sub) {
      if (sub * 32 <= cmax_w) {
#pragma unroll
        for (int i = 0; i < 16; ++i) S[sub][i] = 0.f;
#pragma unroll
        for (int ks = 0; ks < 8; ++ks) {
          bf16x8 kf = *(const bf16x8*)(KcL + (sub * 32 + r) * 272 + (ks * 16 + hh * 8) * 2);
          S[sub] = MFMA32(kf, Qf[ks], S[sub]);
        }
#pragma unroll
        for (int i = 0; i < 16; ++i) {
          bool ok = (sub * 32 + crow(i, hh)) <= cmax;
          S[sub][i] = ok ? S[sub][i] : -1e30f;
          mx = fmaxf(mx, S[sub][i]);
        }
      } else {
#pragma unroll
        for (int i = 0; i < 16; ++i) S[sub][i] = -1e30f;
      }
    }
    mx = fmaxf(mx, xhalf(mx, r, hh));
    float ps = 0.f;
#pragma unroll
    for (int sub = 0; sub < 4; ++sub) {
      if (sub * 32 <= cmax_w) {
#pragma unroll
        for (int i = 0; i < 16; ++i) {
          float pv = (S[sub][i] > -1e29f) ? ex2(S[sub][i] - mx) : 0.f;
          ps += pv;
          S[sub][i] = pv;
        }
      } else {
#pragma unroll
        for (int i = 0; i < 16; ++i) S[sub][i] = 0.f;
      }
    }
    ps += xhalf(ps, r, hh);
    float inv = 1.f / fmaxf(ps, 1e-30f);
#pragma unroll
    for (int sub = 0; sub < 4; ++sub)
#pragma unroll
      for (int i = 0; i < 16; ++i) S[sub][i] *= inv;
    bf16x8 pf[4][2];
#pragma unroll
    for (int sub = 0; sub < 4; ++sub) {
      pf[sub][0] = pack8(S[sub], 0);
      pf[sub][1] = pack8(S[sub], 1);
      if (sub * 32 <= cmax_w) {
#pragma unroll
        for (int i = 0; i < 16; ++i) {
          float v = S[sub][i];
          v += dpp_xor1(v);
          v += dpp_xor2(v);
          if ((r & 3) == 0) psum[tokl * 129 + sub * 32 + crow(i, hh)] = v;
        }
      } else if ((r & 3) == 0) {
#pragma unroll
        for (int i = 0; i < 16; ++i) psum[tokl * 129 + sub * 32 + crow(i, hh)] = 0.f;
      }
    }
    __builtin_amdgcn_sched_barrier(0);
#pragma unroll
    for (int dt = 0; dt < 4; ++dt)
#pragma unroll
      for (int i = 0; i < 16; ++i) Oc[dt][i] = 0.f;
#pragma unroll
    for (int sub = 0; sub < 4; ++sub) {
      if (sub * 32 <= cmax_w)
#pragma unroll
      for (int dt = 0; dt < 4; ++dt) {
        const char* vrow = VcL + (dt * 32 + r) * 264 + sub * 64 + hh * 8;
        bf16x8 v0 = lds_vfrag(vrow);
        bf16x8 v1 = lds_vfrag(vrow + 32);
        Oc[dt] = MFMA32(v0, pf[sub][0], Oc[dt]);
        Oc[dt] = MFMA32(v1, pf[sub][1], Oc[dt]);
      }
    }
  }
  __syncthreads();
#pragma unroll
  for (int dt = 0; dt < 4; ++dt)
#pragma unroll
    for (int s2 = 0; s2 < 2; ++s2) *(bf16x8*)(OcL + wid * 8192 + (dt * 2 + s2) * 1024 + lane * 16) = pack8(Oc[dt], s2);
  {
    const int tl = lane >> 3, jq = lane & 7;
    const int tk2 = wid * 8 + tl;
    const int t2 = q0 + tk2;
    const int cur = t2 >> 6;
    float my[4];
#pragma unroll
    for (int e = 0; e < 4; ++e) {
      int j = jq * 4 + e;
      float s = 0.f;
#pragma unroll
      for (int dc = -1; dc <= 3; ++dc) {
        int c = 4 * j + dc;
        if (c >= 0 && c < 127) s += psum[tk2 * 129 + c];
      }
      bool forced = (j == 0) || (j == cur) || (j == cur - 1);
      bool val = j <= cur;
      my[e] = forced ? 1e4f : (val ? s : -1.f);
      scs[tk2 * 33 + j] = my[e];
    }
    __syncthreads();
    unsigned bits = 0;
    int cnt[4] = {0, 0, 0, 0};
#pragma unroll 8
    for (int jj = 0; jj < 32; ++jj) {
      float v = scs[tk2 * 33 + jj];
#pragma unroll
      for (int e = 0; e < 4; ++e) {
        int j = jq * 4 + e;
        cnt[e] += ((v > my[e]) || (v == my[e] && jj < j)) ? 1 : 0;
      }
    }
#pragma unroll
    for (int e = 0; e < 4; ++e)
      if (cnt[e] < 16) bits |= 1u << (jq * 4 + e);
    bits |= SWZ_XOR_U(bits, 1);
    bits |= SWZ_XOR_U(bits, 2);
    bits |= SWZ_XOR_U(bits, 4);
    if (jq == 0) smask[tk2] = bits;
  }
  __syncthreads();
  const unsigned mymask = smask[tokl];
  f32x16 O[4];
#pragma unroll
  for (int dt = 0; dt < 4; ++dt)
#pragma unroll
    for (int i = 0; i < 16; ++i) O[dt][i] = 0.f;
  float m = -1e30f, l = 0.f;
  {
    const bf16_t* ksrc = (const bf16_t*)(p.ws + OFF_KSA) + (size_t)(b * 2 + h) * 2048 * 128;
    const bf16_t* vsrc = (const bf16_t*)(p.ws + OFF_VSAT) + (size_t)(b * 2 + h) * 128 * 2048;
    __syncthreads();
    char* const KB = g_shm + 65536;
    char* const VB = g_shm + 100352;
    pf.commit(KB, VB, tid);
    if (1 <= qb) pf.issue(ksrc + (size_t)64 * 128, vsrc + 64, tid);
    __syncthreads();
    const bool late = p.wv >= 4;
    PFrag Pc;
    bool have = false;
    int vprev = 0;
    for (int jb = 0; jb <= qb; ++jb) {
      const int cur = jb & 1, vc = jb % 3;
      if (late && have) { attn_pv<128>(VB + vprev * 18432, O, Pc, r, hh); have = false; }
      const bool sel = (mymask >> jb) & 1u;
      if (__builtin_amdgcn_ballot_w64(sel) != 0ull) {
        const int key0 = jb * 64;
        auto vf = [&](int kl) { return (key0 + kl) <= t; };
        PFrag Pn;
        attn_scores<128>(KB + cur * 17408, Qf, O, m, l, r, hh, sel, jb == qb, jb == 0, vf, Pn);
        if (late) { Pc = Pn; have = true; vprev = vc; }
        else attn_pv<128>(VB + vc * 18432, O, Pn, r, hh);
      }
      if (jb + 1 <= qb) {
        pf.commit(KB + (cur ^ 1) * 17408, VB + ((vc + 1) % 3) * 18432, tid);
        if (jb + 2 <= qb) pf.issue(ksrc + (size_t)(jb + 2) * 64 * 128, vsrc + (jb + 2) * 64, tid);
      }
      __syncthreads();
    }
    if (late && have) attn_pv<128>(VB + vprev * 18432, O, Pc, r, hh);
    __syncthreads();
  }
  {
    const int tid2 = otid(p.wv);
    const int wid = tid2 >> 6, lane = tid2 & 63;
    const int r = lane & 31, hh = lane >> 5;
    const int tokl = wid * 8 + (r >> 2);
    const int t = q0 + tokl;
    const int head = h * 4 + (r & 3);
    const float* gt = (const float*)(p.ws + OFF_GATES) + (size_t)(b * 2048 + t) * 24 + head * 3;
    const float lt = l + xhalf(l, r, hh);
    const float g0 = gt[0], g1 = gt[1] / fmaxf(lt, 1e-30f), g2 = gt[2];
    char* lw = g_shm + 68608 + wid * 8448;
    const size_t tok0 = (size_t)(b * 2048 + q0 + wid * 8);
    uint2 wr_[4][4], zr_[4][4];
    wtile_load<4, 256, 8>((const bf16_t*)(p.ws + OFF_OWIN) + tok0 * 1024 + h * 512, 1024, lw, lane);
#pragma unroll
    for (int dt = 0; dt < 4; ++dt)
#pragma unroll
      for (int g = 0; g < 4; ++g) wr_[dt][g] = *(const uint2*)(lw + r * 264 + (dt * 32 + 8 * g + 4 * hh) * 2);
    wtile_load<4, 256, 8>((const bf16_t*)(p.ws + OFF_ZA) + tok0 * 1024 + h * 512, 1024, lw, lane);
#pragma unroll
    for (int dt = 0; dt < 4; ++dt)
#pragma unroll
      for (int g = 0; g < 4; ++g) zr_[dt][g] = *(const uint2*)(lw + r * 264 + (dt * 32 + 8 * g + 4 * hh) * 2);
#pragma unroll
    for (int dt = 0; dt < 4; ++dt)
#pragma unroll
      for (int g = 0; g < 4; ++g) {
        uint2 w = wr_[dt][g];
        uint2 z = zr_[dt][g];
        float w0 = __uint_as_float(w.x << 16), w1 = __uint_as_float(w.x & 0xffff0000u), w2 = __uint_as_float(w.y << 16), w3 = __uint_as_float(w.y & 0xffff0000u);
        float z0 = __uint_as_float(z.x << 16), z1 = __uint_as_float(z.x & 0xffff0000u), z2 = __uint_as_float(z.y << 16), z3 = __uint_as_float(z.y & 0xffff0000u);
        uint2 c = *(const uint2*)(OcL + wid * 8192 + (dt * 2 + (g >> 1)) * 1024 + lane * 16 + (g & 1) * 8);
        float c0 = __uint_as_float(c.x << 16), c1 = __uint_as_float(c.x & 0xffff0000u), c2 = __uint_as_float(c.y << 16), c3 = __uint_as_float(c.y & 0xffff0000u);
        float a0 = (g0 * c0 + g1 * O[dt][4 * g] + g2 * w0) * z0;
        float a1 = (g0 * c1 + g1 * O[dt][4 * g + 1] + g2 * w1) * z1;
        float a2 = (g0 * c2 + g1 * O[dt][4 * g + 2] + g2 * w2) * z2;
        float a3 = (g0 * c3 + g1 * O[dt][4 * g + 3] + g2 * w3) * z3;
        uint2 o;
        o.x = pack2(a0, a1);
        o.y = pack2(a2, a3);
        *(uint2*)(lw + r * 264 + (dt * 32 + 8 * g + 4 * hh) * 2) = o;
      }
    wtile_store<4, 256, 8>((bf16_t*)(p.ws + OFF_Y) + tok0 * 2048 + h * 512, 2048, lw, lane);
  }
}

DI void phase_mix2(const Params& p) {
  int* ctr = (int*)(p.ws + OFF_MISC + MISC_CTR) + 16;
  if (gridDim.x == 256) {
    const int c = blockIdx.x, bh = c & 15, x = c >> 4;
    item_nsa(p, bh >> 1, bh & 1, 31 - x);
    item_nsa(p, bh >> 1, bh & 1, x);
    return;
  }
  for (;;) {
    int it = next_item(p.wv, ctr);
    if (it >= 512) break;
    int qb = 31 - (it >> 4), bh = it & 15;
    item_nsa(p, bh >> 1, bh & 1, qb);
  }
}

DI void phase_out(const Params& p) {
  const bf16_t* y = (const bf16_t*)(p.ws + OFF_Y);
  const bf16_t* wto = (const bf16_t*)(p.ws + OFF_WTOUT);
  float* rowss = (float*)(p.ws + OFF_MISC + MISC_ROWSS);
  const int tid = otid(p.wv), wid = tid >> 6, lane = tid & 63, wr = wid >> 2, wc = wid & 3, fr = lane & 15, fq = lane >> 4;
  for (int L = blockIdx.x; L < 64 * 8; L += gridDim.x) {
    int pm, pn;
    unit_order(L, 64, 8, pm, pn);
    f32x4 acc[8][4];
    gemm_mainloop(p.wv, y + (size_t)pm * 256 * DM, DM, wto + (size_t)pn * 256 * DM, DM, DM / 64, acc);
    const float* __restrict__ xin = p.x;
    float* __restrict__ xout = p.out;
#pragma unroll
    for (int m = 0; m < 8; ++m) {
      float xv[4][4];
#pragma unroll
      for (int j = 0; j < 4; ++j)
#pragma unroll
        for (int n = 0; n < 4; ++n)
          xv[j][n] = xin[((size_t)pm * 256 + wr * 128 + m * 16 + fq * 4 + j) * DM + pn * 256 + wc * 64 + n * 16 + fr];
#pragma unroll
      for (int j = 0; j < 4; ++j) {
        size_t row = (size_t)pm * 256 + wr * 128 + m * 16 + fq * 4 + j;
        float ss = 0.f;
#pragma unroll
        for (int n = 0; n < 4; ++n) {
          size_t idx = row * DM + pn * 256 + wc * 64 + n * 16 + fr;
          float v = xv[j][n] + acc[m][n][j];
          xout[idx] = v;
          ss += v * v;
        }
        ss += SWZ_XOR_F(ss, 1);
        ss += SWZ_XOR_F(ss, 2);
        ss += SWZ_XOR_F(ss, 4);
        ss += SWZ_XOR_F(ss, 8);
        if (fr == 0) atomicAdd(rowss + row, ss);
      }
    }
  }
}

DI void phase_out_fused(const Params& p) {
  const bf16_t* y = (const bf16_t*)(p.ws + OFF_Y);
  const bf16_t* wto = (const bf16_t*)(p.ws + OFF_WTOUT);
  float* rowss = (float*)(p.ws + OFF_MISC + MISC_ROWSS);
  unsigned* pcnt = (unsigned*)(p.ws + OFF_MISC + MISC_CTR) + 64;
  const int c = blockIdx.x, xcd = c & 7, slot = c >> 3, grp = slot >> 3, pn = slot & 7;
  for (int i = 0; i < 2; ++i) {
    const int pm = i * 32 + xcd * 4 + grp;
    f32x4 acc[8][4];
    gemm_mainloop8<true>(p.wv, y + (size_t)pm * 256 * DM, DM, wto + (size_t)pn * 256 * DM, DM, DM / 64, acc);
    const int lane = olane(), fr = lane & 15, fq = lane >> 4;
    const int wr_s = p.wv >> 2, wc_s = p.wv & 3;
    const size_t ubase = ((size_t)pm * 256 + wr_s * 64) * DM + pn * 256 + wc_s * 32;
    const float* __restrict__ xb = p.x + ubase;
    float* __restrict__ ob = p.out + ubase;
    float* rs = rowss + pm * 256 + wr_s * 64;
    const unsigned lo = (unsigned)(fr * DM + fq * 4);
#define MOFF(m) (((((m) >> 2) * 128) + (((m) & 3) * 16)) * DM)
#define MROW(m) ((((m) >> 2) * 128) + (((m) & 3) * 16))
#define NOFF(n) ((((n) >> 1) * 128) + (((n) & 1) * 16))
    {
#define XLOAD(dst, mb) _Pragma("unroll") for (int mi = 0; mi < 2; ++mi) _Pragma("unroll") for (int n = 0; n < 4; ++n) \
    dst[mi][n] = __builtin_nontemporal_load((const f32x4*)(xb + MOFF((mb) + mi) + NOFF(n) + lo))
#define XADD(src, mb) _Pragma("unroll") for (int mi = 0; mi < 2; ++mi) _Pragma("unroll") for (int n = 0; n < 4; ++n) acc[(mb) + mi][n] += src[mi][n]
      f32x4 xa[2][4], xb2[2][4];
      XLOAD(xa, 0); XLOAD(xb2, 2);
      __builtin_amdgcn_sched_barrier(0);
      XADD(xa, 0); XLOAD(xa, 4);
      __builtin_amdgcn_sched_barrier(0);
      XADD(xb2, 2); XLOAD(xb2, 6);
      __builtin_amdgcn_sched_barrier(0);
      XADD(xa, 4);
      __builtin_amdgcn_sched_barrier(0);
      XADD(xb2, 6);
      __builtin_amdgcn_sched_barrier(0);
#undef XLOAD
#undef XADD
    }
#pragma unroll
    for (int m = 0; m < 8; ++m) {
      float ss = 0.f;
#pragma unroll
      for (int n = 0; n < 4; ++n)
        ss += acc[m][n][0] * acc[m][n][0] + acc[m][n][1] * acc[m][n][1] + acc[m][n][2] * acc[m][n][2] + acc[m][n][3] * acc[m][n][3];
      ss += SWZ_XOR_F(ss, 16);
      ss += xhalf(ss, lane & 31, lane >> 5);
      if (fq == 0) atomicAdd(rs + MROW(m) + fr, ss);
    }
    asm volatile("s_waitcnt vmcnt(0)" ::: "memory");
    __syncthreads();
    if (p.wv == 0 && lane == 0) {
      asm volatile("" ::: "memory");
      __hip_atomic_fetch_add(pcnt + pm, 1u, __ATOMIC_RELAXED, __HIP_MEMORY_SCOPE_AGENT);
      unsigned sp = 0;
      while (__hip_atomic_load(pcnt + pm, __ATOMIC_RELAXED, __HIP_MEMORY_SCOPE_AGENT) < 8u) {
        __builtin_amdgcn_s_sleep(1);
        if (++sp > (1u << 22)) break;
      }
      asm volatile("" ::: "memory");
    }
    __syncthreads();
    f32x4 gv[4];
#pragma unroll
    for (int n = 0; n < 4; ++n) gv[n] = *(const f32x4*)(p.final_g + pn * 256 + wc_s * 32 + NOFF(n) + fq * 4);
    float tot[8];
#pragma unroll
    for (int m = 0; m < 8; ++m) tot[m] = __hip_atomic_load(rs + MROW(m) + fr, __ATOMIC_RELAXED, __HIP_MEMORY_SCOPE_AGENT);
#pragma unroll
    for (int m = 0; m < 8; ++m) {
      const float rstd = rsqrtf(tot[m] * (1.f / DM) + 1e-6f);
#pragma unroll
      for (int n = 0; n < 4; ++n) __builtin_nontemporal_store(acc[m][n] * rstd * gv[n], (f32x4*)(ob + MOFF(m) + NOFF(n) + lo));
    }
#undef MOFF
#undef MROW
#undef NOFF
  }
}

DI void phase_final(const Params& p) {
  const int tid = otid(p.wv), wid = tid >> 6, lane = tid & 63;
  const float* rowss = (const float*)(p.ws + OFF_MISC + MISC_ROWSS);
  const float4* g4 = (const float4*)p.final_g;
  for (int row = blockIdx.x * 8 + wid; row < T_TOK; row += gridDim.x * 8) {
    float rstd = rsqrtf(rowss[row] * (1.f / DM) + 1e-6f);
    float4* o = (float4*)(p.out + (size_t)row * DM);
    float4 v[8], g[8];
#pragma unroll
    for (int i = 0; i < 8; ++i) { v[i] = o[lane + 64 * i]; g[i] = g4[lane + 64 * i]; }
#pragma unroll
    for (int i = 0; i < 8; ++i) {
      float4 t = v[i];
      t.x *= rstd * g[i].x; t.y *= rstd * g[i].y; t.z *= rstd * g[i].z; t.w *= rstd * g[i].w;
      o[lane + 64 * i] = t;
    }
  }
}


#define XB_TMO      128
#define XB_XCNT(j)  (256  + 64 * (j))
#define XB_XSUB(j)  (1280 + 64 * (j))
#define XB_XGEN(j)  (2304 + 64 * (j))
#define XB_TOP      3328
#define XB_TOPGEN   3392
#define XCD_BAR_WORDS 3456
#define XB_SPIN_CAP (1u << 20)
DI unsigned xb_ld(unsigned* p) { return __hip_atomic_load(p, __ATOMIC_RELAXED, __HIP_MEMORY_SCOPE_AGENT); }
DI unsigned xb_add(unsigned* p, unsigned v) { return __hip_atomic_fetch_add(p, v, __ATOMIC_RELAXED, __HIP_MEMORY_SCOPE_AGENT); }
DI unsigned xb_xcc_id() { return (unsigned)__builtin_amdgcn_s_getreg((3 << 11) | 20) & 0xFu; }
#define XB_SPIN(cond, bar) do { unsigned _sp = 0; while (cond) { __builtin_amdgcn_s_sleep(1); \
    if ((++_sp & 255u) == 0u) { if (xb_ld(&(bar)[XB_TMO])) break; if (_sp > XB_SPIN_CAP) { atomicAdd(&(bar)[XB_TMO], 1u); break; } } } } while (0)
DI void xcd_barrier_complete(unsigned* bar, unsigned x, unsigned& nloc, unsigned& nx) {
  const unsigned G = gridDim.x;
  unsigned sum, cnt, mine, sp = 0u;
  for (;;) {
    sum = 0u; cnt = 0u; mine = 0u;
#pragma unroll
    for (unsigned j = 0; j < 16; ++j) { const unsigned c = xb_ld(&bar[XB_XCNT(j)]); sum += c; cnt += (c > 0u) ? 1u : 0u; mine = (j == x) ? c : mine; }
    if (sum == G) break;
    __builtin_amdgcn_s_sleep(1);
    if ((++sp & 255u) == 0u) { if (xb_ld(&bar[XB_TMO])) break; if (sp > XB_SPIN_CAP) { atomicAdd(&bar[XB_TMO], 1u); break; } }
  }
  nloc = mine > 0u ? mine : 1u; nx = cnt > 0u ? cnt : 1u;
}
DI void xcd_barrier(int wv, unsigned* bar, unsigned x, volatile unsigned* st) {
  asm volatile("s_waitcnt vmcnt(0)" ::: "memory");
  __syncthreads();
  if (otid(wv) == 0) {
    __builtin_amdgcn_s_waitcnt(0);
    unsigned nloc = st[0], nx = st[1];
    if (nloc == 0u) { xcd_barrier_complete(bar, x, nloc, nx); st[0] = nloc; st[1] = nx; }
    const unsigned old = xb_add(&bar[XB_XSUB(x)], 1u);
    const unsigned gen = old / nloc;
    if (old + 1u == (gen + 1u) * nloc) {
      __builtin_amdgcn_fence(__ATOMIC_RELEASE, "agent");
      asm volatile("s_waitcnt vmcnt(0)" ::: "memory");
      const unsigned og = xb_add(&bar[XB_TOP], 1u);
      const unsigned tg = og / nx;
      if (og + 1u == (tg + 1u) * nx) xb_add(&bar[XB_TOPGEN], 1u);
      else XB_SPIN(xb_ld(&bar[XB_TOPGEN]) == tg, bar);
      __builtin_amdgcn_fence(__ATOMIC_ACQUIRE, "agent");
      xb_add(&bar[XB_XGEN(x)], 1u);
      asm volatile("s_waitcnt vmcnt(0)" ::: "memory");
    } else {
      XB_SPIN(xb_ld(&bar[XB_XGEN(x)]) == gen, bar);
      __builtin_amdgcn_fence(__ATOMIC_ACQUIRE, "agent");
      asm volatile("s_waitcnt vmcnt(0)" ::: "memory");
    }
  }
  __syncthreads();
}

template <int PH>
__global__ void __launch_bounds__(NTHR) fwd_kernel(Params p) {
  if constexpr (PH == -1) {
    cg::grid_group grid = cg::this_grid();
    p.wv = __builtin_amdgcn_readfirstlane((int)(threadIdx.x >> 6));
    if (p.ws == nullptr) grid.sync();
    unsigned* bar = (unsigned*)(p.ws + OFF_BAR);
    volatile unsigned* st = (volatile unsigned*)(g_shm + SHM_BYTES - 32);
    if (otid(p.wv) == 0) { st[0] = 0u; st[1] = 0u; }
    __syncthreads();
    const unsigned xcc = xb_xcc_id();
    if (otid(p.wv) == 0) (void)xb_add(&bar[XB_XCNT(xcc)], 1u);
    phase_prep(p);
    xcd_barrier(p.wv, bar, xcc, st);
    phase_proj(p);
    xcd_barrier(p.wv, bar, xcc, st);
    phase_mix1(p);
    xcd_barrier(p.wv, bar, xcc, st);
    phase_mix2(p);
    xcd_barrier(p.wv, bar, xcc, st);
    if (gridDim.x == 256) {
      phase_out_fused(p);
    } else {
      phase_out(p);
      xcd_barrier(p.wv, bar, xcc, st);
      phase_final(p);
    }
  } else { p.wv = __builtin_amdgcn_readfirstlane((int)(threadIdx.x >> 6)); if constexpr (PH == 0) phase_prep(p);
  else if constexpr (PH == 1) phase_proj(p);
  else if constexpr (PH == 2) phase_mix1(p);
  else if constexpr (PH == 6) phase_cmp2(p);
  else if constexpr (PH == 3) phase_mix2(p);
  else if constexpr (PH == 4) phase_out(p);
  else phase_final(p); }
}

extern "C" void kernel_launch(void* const* d_in, const int* in_sizes, int n_in, void* d_out, int out_size, void* d_ws, size_t ws_size,
                              hipStream_t stream) {
  Params p{};
  p.x = (const float*)d_in[0];
  p.w_in = (const float*)d_in[1];
  p.k_w1 = (const float*)d_in[2];
  p.k_w2 = (const float*)d_in[3];
  p.v_w1 = (const float*)d_in[4];
  p.v_w2 = (const float*)d_in[5];
  p.k_pos = (const float*)d_in[6];
  p.v_pos = (const float*)d_in[7];
  p.sinks = (const float*)d_in[8];
  p.w_out = (const float*)d_in[9];
  p.norm_g = (const float*)d_in[10];
  p.final_g = (const float*)d_in[11];
  p.out = (float*)d_out;
  p.ws = (char*)d_ws;
#if MULTI_LAUNCH
  const int grid = 256;
  fwd_kernel<0><<<grid, NTHR, 0, stream>>>(p);
  fwd_kernel<1><<<grid, NTHR, 0, stream>>>(p);
  fwd_kernel<2><<<grid, NTHR, 0, stream>>>(p);
  fwd_kernel<6><<<grid, NTHR, 0, stream>>>(p);
  fwd_kernel<3><<<grid, NTHR, 0, stream>>>(p);
  fwd_kernel<4><<<grid, NTHR, 0, stream>>>(p);
  fwd_kernel<5><<<grid, NTHR, 0, stream>>>(p);
#else
  static int grid_blocks = 0;
  if (!grid_blocks) {
    int dev = 0, cus = 0, per_cu = 0;
    hipGetDevice(&dev);
    hipDeviceGetAttribute(&cus, hipDeviceAttributeMultiprocessorCount, dev);
    hipOccupancyMaxActiveBlocksPerMultiprocessor(&per_cu, fwd_kernel<-1>, NTHR, 0);
    if (per_cu < 1) per_cu = 1;
    if (per_cu > 1) per_cu = 1;
    grid_blocks = cus * per_cu;
  }
  hipMemsetAsync((char*)d_ws + OFF_BAR, 0, XCD_BAR_WORDS * 4, stream);
  void* args[] = {&p};
  hipError_t e = hipLaunchCooperativeKernel((void*)fwd_kernel<-1>, dim3(grid_blocks), dim3(NTHR), args, 0, stream);
  if (e != hipSuccess) fprintf(stderr, "cooperative launch failed: %s (grid %d)\n", hipGetErrorString(e), grid_blocks);
#endif
}
```

```cpp
#include <hip/hip_runtime.h>
#include <hip/hip_cooperative_groups.h>
#include <cstdio>
namespace cg = cooperative_groups;

#ifndef MULTI_LAUNCH
#define MULTI_LAUNCH 0
#endif

typedef unsigned short bf16_t;
typedef short bf16x8 __attribute__((ext_vector_type(8)));
typedef float f32x4 __attribute__((ext_vector_type(4)));
typedef unsigned u32x4 __attribute__((ext_vector_type(4)));
typedef float f32x16 __attribute__((ext_vector_type(16)));
#define DI __device__ __forceinline__
#define MFMA16(a, b, c) __builtin_amdgcn_mfma_f32_16x16x32_bf16((a), (b), (c), 0, 0, 0)
#define MFMA32(a, b, c) __builtin_amdgcn_mfma_f32_32x32x16_bf16((a), (b), (c), 0, 0, 0)
#define WAIT_V0() asm volatile("s_waitcnt vmcnt(0)" ::: "memory")

constexpr int NTHR = 512;
constexpr int T_TOK = 16384, SEQ = 2048, DM = 2048;
constexpr int N1 = 6144;
constexpr float LOG2E = 1.4426950408889634f;

struct Params {
  const float *x, *w_in, *k_w1, *k_w2, *v_w1, *v_w2, *k_pos, *v_pos, *sinks, *w_out, *norm_g, *final_g;
  float* out;
  char* ws;
  int wv;
  int pad_;
};

constexpr size_t MiB = 1u << 20;
constexpr size_t OFF_HB = 0, OFF_WTIN = 64 * MiB, OFF_WTOUT = 88 * MiB, OFF_W1T = 96 * MiB, OFF_W2T = 100 * MiB, OFF_MISC = 101 * MiB,
                 OFF_QA = 104 * MiB, OFF_KCA = 136 * MiB, OFF_VCA = 144 * MiB, OFF_KSA = 152 * MiB, OFF_VSAT = 160 * MiB, OFF_KWA = 168 * MiB,
                 OFF_VWAT = 176 * MiB, OFF_ZA = 184 * MiB, OFF_GATES = 216 * MiB, OFF_QB = 218 * MiB, OFF_KB = 250 * MiB, OFF_VBT = 254 * MiB,
                 OFF_ZB = 258 * MiB, OFF_KC = 290 * MiB, OFF_VCT = 291 * MiB, OFF_OWIN = 292 * MiB, OFF_Y = 324 * MiB;
constexpr size_t OFF_BAR = 103 * MiB;
constexpr size_t OFF_CPART = 400 * MiB;
constexpr size_t MISC_CTR = 0, MISC_ROWSS = 4096, MISC_BIASP = 128 * 1024, MISC_TAB128 = 256 * 1024, MISC_TAB64 = 256 * 1024 + MiB;

constexpr int SHM_BYTES = 157696;
__shared__ __attribute__((aligned(1024))) char g_shm[SHM_BYTES];

DI unsigned short f2bf(float x) {
  unsigned u = __float_as_uint(x);
  u += 0x7fffu + ((u >> 16) & 1u);
  return (unsigned short)(u >> 16);
}
typedef __bf16 hbf16x2 __attribute__((ext_vector_type(2)));
typedef float f32x2 __attribute__((ext_vector_type(2)));
DI unsigned pack2(float a, float b) {
  f32x2 v = {a, b};
  return __builtin_bit_cast(unsigned, __builtin_convertvector(v, hbf16x2));
}
DI float silu_f(float v) { return v * __builtin_amdgcn_rcpf(1.f + __expf(-v)); }
DI float sigmoid_f(float v) { return __builtin_amdgcn_rcpf(1.f + __expf(-v)); }
DI float ex2(float v) { return __builtin_amdgcn_exp2f(v); }
DI int crow(int i, int hh) { return (i & 3) + 8 * (i >> 2) + 4 * hh; }
DI float dpp_xor1(float v) { return __int_as_float(__builtin_amdgcn_mov_dpp(__float_as_int(v), 0xB1, 0xF, 0xF, true)); }
DI float dpp_xor2(float v) { return __int_as_float(__builtin_amdgcn_mov_dpp(__float_as_int(v), 0x4E, 0xF, 0xF, true)); }
DI float xhalf(float v, int r, int hh) {
  int rr = r;
  asm volatile("" : "+v"(rr));
  return __int_as_float(__builtin_amdgcn_ds_bpermute((rr | ((hh ^ 1) << 5)) << 2, __float_as_int(v)));
}
DI int olane() {
  int l;
  asm volatile("v_mbcnt_lo_u32_b32 %0, -1, 0\n\tv_mbcnt_hi_u32_b32 %0, -1, %0" : "=v"(l));
  return l;
}
DI int otid(int wv) { return (wv << 6) | olane(); }
DI float swz_xor(float v, int k) { return v; }
#define SWZ_XOR_F(v, k) __int_as_float(__builtin_amdgcn_ds_swizzle(__float_as_int(v), ((k) << 10) | 0x1F))
#define SWZ_XOR_U(v, k) ((unsigned)__builtin_amdgcn_ds_swizzle((int)(v), ((k) << 10) | 0x1F))

DI int win_col(int np) {
  if (np >= 5912) return -1;
  if (np >= 5888) return np - 5888 + 3584;
  if (np >= 3584) return np + 24;
  bool roped = (np < 1280) || (np >= 1536 && np < 1792) || (np >= 2048 && np < 2304);
  if (!roped) return np;
  int base = np & ~127, pp = np & 127;
  int w = pp >> 6, n = (pp >> 4) & 3, fr = pp & 15;
  int d = ((n & 2) ? 64 : 0) + 32 * w + 16 * (n & 1) + fr;
  return base + d;
}

struct TDesc { const float* src; bf16_t* dst; int ld_src, ld_dst, k0, n0, mode; };
DI void tile_load(const TDesc& d, int tid, f32x4& v0, f32x4& v1) {
  const int n4 = tid & 15, kr = tid >> 4;
  int np = d.n0 + 4 * n4;
  int oc = np;
  if (d.mode == 1) {
    const int q = np & 255;
    np = (np & ~255) + ((q >> 5) & 3) * 64 + (q >> 7) * 32 + ((q >> 4) & 1) * 16 + (q & 15);
    oc = win_col(np);
  }
  v0 = f32x4{0.f, 0.f, 0.f, 0.f};
  v1 = f32x4{0.f, 0.f, 0.f, 0.f};
  if (oc >= 0) {
    v0 = __builtin_nontemporal_load((const f32x4*)(d.src + (size_t)(d.k0 + kr) * d.ld_src + oc));
    v1 = __builtin_nontemporal_load((const f32x4*)(d.src + (size_t)(d.k0 + kr + 32) * d.ld_src + oc));
  }
}
DI void tile_finish(const TDesc& d, int tid, const f32x4& v0, const f32x4& v1) {
  float* tile = (float*)g_shm;
  {
    const int n4 = tid & 15, kr = tid >> 4;
#pragma unroll
    for (int e = 0; e < 4; ++e) {
      tile[(4 * n4 + e) * 65 + kr] = v0[e];
      tile[(4 * n4 + e) * 65 + kr + 32] = v1[e];
    }
  }
  __syncthreads();
  {
    const int k8 = tid & 7, n = tid >> 3;
    const float* t = tile + n * 65 + k8 * 8;
    u32x4 o;
    o[0] = pack2(t[0], t[1]);
    o[1] = pack2(t[2], t[3]);
    o[2] = pack2(t[4], t[5]);
    o[3] = pack2(t[6], t[7]);
    *(u32x4*)(d.dst + (size_t)(d.n0 + n) * d.ld_dst + d.k0 + k8 * 8) = o;
  }
  __syncthreads();
}
DI void tile_decode(const Params& p, int it, TDesc& d) {
  constexpr int I_WIN = 96 * 32, I_WOUT = 32 * 32, I_W1 = 4 * 64, I_W2 = 2 * 4;
  int i = it;
  if (i < I_WIN) { d = TDesc{p.w_in, (bf16_t*)(p.ws + OFF_WTIN), 5912, 2048, (i & 31) * 64, (i >> 5) * 64, 1}; return; }
  i -= I_WIN;
  if (i < I_WOUT) { d = TDesc{p.w_out, (bf16_t*)(p.ws + OFF_WTOUT), 2048, 2048, (i & 31) * 64, (i >> 5) * 64, 0}; return; }
  i -= I_WOUT;
  if (i < 2 * I_W1) {
    const int mat = i / I_W1; i %= I_W1;
    d = TDesc{mat ? p.v_w1 : p.k_w1, (bf16_t*)(p.ws + OFF_W1T) + (size_t)mat * 256 * 4096, 256, 4096, (i & 63) * 64, (i >> 6) * 64, 0};
    return;
  }
  i -= 2 * I_W1;
  {
    const int mat = i / I_W2; i %= I_W2;
    d = TDesc{mat ? p.v_w2 : p.k_w2, (bf16_t*)(p.ws + OFF_W2T) + (size_t)mat * 128 * 256, 128, 256, (i & 3) * 64, (i >> 2) * 64, 0};
  }
}

DI void phase_prep(const Params& p) {
  const int tid = otid(p.wv), wid = tid >> 6, lane = tid & 63;
  char* misc = p.ws + OFF_MISC;
  for (int i = blockIdx.x * NTHR + tid; i < 1024 + T_TOK; i += gridDim.x * NTHR) ((float*)misc)[i] = 0.f;
  {
    float2* t128 = (float2*)(misc + MISC_TAB128);
    for (int i = blockIdx.x * NTHR + tid; i < SEQ * 64; i += gridDim.x * NTHR) {
      int pos = i >> 6, f = i & 63;
      float inv = (float)exp2(-(double)(2 * f) / 128.0 * 13.287712379549449);
      float ang = (float)pos * inv;
      double a = (double)ang;
      double kk = rint(a * 0.15915494309189535);
      float rr = (float)(a - kk * 6.283185307179586);
      t128[i] = make_float2(cosf(rr), sinf(rr));
    }
    float2* t64 = (float2*)(misc + MISC_TAB64);
    for (int i = blockIdx.x * NTHR + tid; i < SEQ * 32; i += gridDim.x * NTHR) {
      int pos = i >> 5, f = i & 31;
      float inv = (float)exp2(-(double)(2 * f) / 64.0 * 13.287712379549449);
      float ang = (float)pos * inv;
      double a = (double)ang;
      double kk = rint(a * 0.15915494309189535);
      float rr = (float)(a - kk * 6.283185307179586);
      t64[i] = make_float2(cosf(rr), sinf(rr));
    }
  }
  {
    bf16_t* hb = (bf16_t*)(p.ws + OFF_HB);
    const float4* g4 = (const float4*)p.norm_g;
    f32x4 nx[8];
    {
      const int row0 = blockIdx.x * 8 + wid;
      if (row0 < T_TOK) {
#pragma unroll
        for (int i = 0; i < 8; ++i) nx[i] = __builtin_nontemporal_load((const f32x4*)(p.x + (size_t)row0 * DM + (lane + 64 * i) * 4));
      }
    }
    for (int row = blockIdx.x * 8 + wid; row < T_TOK; row += gridDim.x * 8) {
      float4 v[8];
      float ss = 0.f;
#pragma unroll
      for (int i = 0; i < 8; ++i) {
        v[i] = make_float4(nx[i][0], nx[i][1], nx[i][2], nx[i][3]);
        ss += v[i].x * v[i].x + v[i].y * v[i].y + v[i].z * v[i].z + v[i].w * v[i].w;
      }
      {
        const int rown = row + gridDim.x * 8;
        if (rown < T_TOK) {
#pragma unroll
          for (int i = 0; i < 8; ++i) nx[i] = __builtin_nontemporal_load((const f32x4*)(p.x + (size_t)rown * DM + (lane + 64 * i) * 4));
        }
      }
      ss += SWZ_XOR_F(ss, 1); ss += SWZ_XOR_F(ss, 2); ss += SWZ_XOR_F(ss, 4); ss += SWZ_XOR_F(ss, 8); ss += SWZ_XOR_F(ss, 16);
      ss += xhalf(ss, lane & 31, lane >> 5);
      float rstd = rsqrtf(ss * (1.f / DM) + 1e-6f);
#pragma unroll
      for (int i = 0; i < 8; ++i) {
        float4 g = g4[lane + 64 * i];
        uint2 o;
        o.x = pack2(v[i].x * rstd * g.x, v[i].y * rstd * g.y);
        o.y = pack2(v[i].z * rstd * g.z, v[i].w * rstd * g.w);
        *(uint2*)(hb + (size_t)row * DM + (lane + 64 * i) * 4) = o;
      }
    }
  }
  {
    constexpr int TOT = 96 * 32 + 32 * 32 + 2 * 4 * 64 + 2 * 2 * 4;
    int it = blockIdx.x;
    TDesc d{}, dn{};
    f32x4 v0, v1, w0, w1;
    if (it < TOT) { tile_decode(p, it, d); tile_load(d, tid, v0, v1); }
    while (it < TOT) {
      const int itn = it + gridDim.x;
      dn = d; w0 = v0; w1 = v1;
      if (itn < TOT) { tile_decode(p, itn, dn); tile_load(dn, tid, w0, w1); }
      tile_finish(d, tid, v0, v1);
      d = dn; v0 = w0; v1 = w1;
      it = itn;
    }
  }
  {
    float* biasp = (float*)(misc + MISC_BIASP);
    float* red = (float*)g_shm;
    for (int it = blockIdx.x; it < 32; it += gridDim.x) {
      int mat = it >> 4, ch = it & 15;
      const float* w1 = mat ? p.v_w1 : p.k_w1;
      const float* pos = mat ? p.v_pos : p.k_pos;
      int n = tid & 255, half = tid >> 8;
      int kb = ch * 256 + half * 128;
      float a = 0.f;
#pragma unroll
      for (int kk = 0; kk < 128; kk += 32) {
        float wv_[32];
#pragma unroll
        for (int u = 0; u < 32; ++u) wv_[u] = w1[(size_t)(kb + kk + u) * 256 + n];
#pragma unroll
        for (int u = 0; u < 32; ++u) a += pos[kb + kk + u] * wv_[u];
      }
      red[tid] = a;
      __syncthreads();
      if (tid < 256) biasp[(mat * 16 + ch) * 256 + tid] = red[tid] + red[tid + 256];
      __syncthreads();
    }
  }
}

DI int lds_byte(int r, int c) {
  int st = (r >> 4) * 2 + (c >> 5), ob = (r & 15) * 64 + (c & 31) * 2;
  return st * 1024 + (ob ^ (((ob >> 9) & 1) << 5));
}
DI void stage_rc(int b, int& R, int& C) {
  int st = b >> 10, sb = b & 1023, swz = sb ^ (((sb >> 9) & 1) << 5);
  R = (st >> 1) * 16 + swz / 64;
  C = (st & 1) * 32 + (swz % 64) / 2;
}

template <bool TRANS = false>
DI void gemm_mainloop(int wv, const bf16_t* __restrict__ Ab, int lda, const bf16_t* __restrict__ Bb, int ldb, int nt, f32x4 (&acc)[8][4], bool active = true) {
  const int tid = otid(wv), wid = tid >> 6, lane = tid & 63, wr = wid >> 2, wc = wid & 3, fr = lane & 15, fq = lane >> 4;
  int sR[4], sC[4];
#pragma unroll
  for (int i = 0; i < 4; ++i) stage_rc(wid * 1024 + i * 8192 + lane * 16, sR[i], sC[i]);
#pragma unroll
  for (int m = 0; m < 8; ++m)
#pragma unroll
    for (int n = 0; n < 4; ++n) acc[m][n] = f32x4{0.f, 0.f, 0.f, 0.f};
#define SA(b) (g_shm + (b) * 65536)
#define SB(b) (g_shm + (b) * 65536 + 32768)
#define GLDS_STAGE(buf, kt)                                                                                                   \
  do {                                                                                                                        \
    _Pragma("unroll") for (int i = 0; i < 4; ++i) {                                                                            \
      __builtin_amdgcn_global_load_lds((const unsigned*)(Ab + (size_t)sR[i] * lda + (kt) * 64 + sC[i]),                        \
                                       (unsigned*)(SA(buf) + wid * 1024 + i * 8192), 16, 0, 0);                                \
      __builtin_amdgcn_global_load_lds((const unsigned*)(Bb + (size_t)sR[i] * ldb + (kt) * 64 + sC[i]),                        \
                                       (unsigned*)(SB(buf) + wid * 1024 + i * 8192), 16, 0, 0);                                \
    }                                                                                                                         \
  } while (0)
#define KSTEP(buf, ks)                                                                                                        \
  do {                                                                                                                        \
    bf16x8 At[8], Bf[4];                                                                                                      \
    _Pragma("unroll") for (int m = 0; m < 8; ++m) At[m] = *(const bf16x8*)(SA(buf) + lds_byte(wr * 128 + m * 16 + fr, (ks) * 32 + fq * 8)); \
    _Pragma("unroll") for (int n = 0; n < 4; ++n) Bf[n] = *(const bf16x8*)(SB(buf) + lds_byte(wc * 64 + n * 16 + fr, (ks) * 32 + fq * 8));  \
    __builtin_amdgcn_s_setprio(1);                                                                                            \
    _Pragma("unroll") for (int m = 0; m < 8; ++m) _Pragma("unroll") for (int n = 0; n < 4; ++n) acc[m][n] = TRANS ? MFMA16(Bf[n], At[m], acc[m][n]) : MFMA16(At[m], Bf[n], acc[m][n]); \
    __builtin_amdgcn_s_setprio(0);                                                                                            \
    __builtin_amdgcn_sched_barrier(0);                                                                                        \
  } while (0)
  GLDS_STAGE(0, 0);
  WAIT_V0();
  __syncthreads();
  for (int t = 0; t < nt; ++t) {
    int cur = t & 1;
    if (t + 1 < nt) GLDS_STAGE(cur ^ 1, t + 1);
    if (active) {
      KSTEP(cur, 0);
      KSTEP(cur, 1);
    }
    WAIT_V0();
    __syncthreads();
  }
#undef KSTEP
#undef GLDS_STAGE
}

#define ROWM(m) ((((m) >> 2) * 128) + wr * 64 + (((m) & 3) * 16))
#define COLN(n) ((((n) >> 1) * 128) + wc * 32 + (((n) & 1) * 16))
template <bool TRANS, bool GATED = false>
DI void gemm_mainloop8(int wv, const bf16_t* __restrict__ A, int lda, const bf16_t* __restrict__ Bt, int ldb, int nt, f32x4 (&acc)[8][4], bool active = true) {
  const int tid = otid(wv), wid = tid >> 6, lane = tid & 63, wr = wid >> 2, wc = wid & 3, fr = lane & 15, fq = lane >> 4;
#define SA8(b, h) (g_shm + ((b) * 2 + (h)) * 16384)
#define SB8(b, h) (g_shm + (4 + (b) * 2 + (h)) * 16384)
  unsigned offA0, offA1, offB0, offB1;
  {
    int r0, c0, r1, c1;
    stage_rc(tid * 16, r0, c0);
    stage_rc(tid * 16 + 8192, r1, c1);
    offA0 = (unsigned)(r0 * lda + c0); offA1 = (unsigned)(r1 * lda + c1);
    offB0 = (unsigned)(r0 * ldb + c0); offB1 = (unsigned)(r1 * ldb + c1);
  }
#define OFFSEL0_lda offA0
#define OFFSEL1_lda offA1
#define OFFSEL0_ldb offB0
#define OFFSEL1_ldb offB1
#define STAGE8(P, BASE, ld, hrow, kt)                                                                                         \
  do {                                                                                                                        \
    const bf16_t* _gb = (BASE) + (size_t)(hrow) * (ld) + (kt) * 64;                                                           \
    __builtin_amdgcn_global_load_lds((const unsigned*)(_gb + OFFSEL0_##ld), (unsigned*)((P) + tid * 16), 16, 0, 0);          \
    __builtin_amdgcn_global_load_lds((const unsigned*)(_gb + OFFSEL1_##ld), (unsigned*)((P) + tid * 16 + 8192), 16, 0, 0);   \
  } while (0)
#define LDA8(dst, b, h)                                                                                                       \
  _Pragma("unroll") for (int m = 0; m < 4; ++m) _Pragma("unroll") for (int k = 0; k < 2; ++k)                                  \
      dst[m][k] = *(const bf16x8*)(SA8(b, h) + lds_byte(wr * 64 + m * 16 + fr, k * 32 + fq * 8))
#define LDB8(dst, b, h)                                                                                                       \
  _Pragma("unroll") for (int n = 0; n < 2; ++n) _Pragma("unroll") for (int k = 0; k < 2; ++k)                                  \
      dst[n][k] = *(const bf16x8*)(SB8(b, h) + lds_byte(wc * 32 + n * 16 + fr, k * 32 + fq * 8))
#define MMA8(ai, bj, At_, Bt_)                                                                                                \
  do {                                                                                                                        \
    if (!GATED || active) {                                                                                                   \
      __builtin_amdgcn_s_setprio(1);                                                                                          \
      _Pragma("unroll") for (int m = 0; m < 4; ++m) _Pragma("unroll") for (int n = 0; n < 2; ++n) _Pragma("unroll") for (int k = 0; k < 2; ++k) \
          acc[(ai) * 4 + m][(bj) * 2 + n] = TRANS ? MFMA16(Bt_[n][k], At_[m][k], acc[(ai) * 4 + m][(bj) * 2 + n])             \
                                                  : MFMA16(At_[m][k], Bt_[n][k], acc[(ai) * 4 + m][(bj) * 2 + n]);             \
      __builtin_amdgcn_s_setprio(0);                                                                                          \
    }                                                                                                                         \
  } while (0)
#define WAITV8(n) asm volatile("s_waitcnt vmcnt(" #n ")" ::: "memory")
#define WAITL8(n) asm volatile("s_waitcnt lgkmcnt(" #n ")" ::: "memory")
#define BAR8 __builtin_amdgcn_s_barrier()
#define SCHED8 __builtin_amdgcn_sched_barrier(0)
#pragma unroll
  for (int m = 0; m < 8; ++m)
#pragma unroll
    for (int n = 0; n < 4; ++n) acc[m][n] = f32x4{0.f, 0.f, 0.f, 0.f};
  bf16x8 At[4][2], B0[2][2], B1[2][2];
  asm volatile("s_waitcnt vmcnt(0) lgkmcnt(0)" ::: "memory");
  BAR8;
  STAGE8(SB8(0, 0), Bt, ldb, 0, 0); STAGE8(SA8(0, 0), A, lda, 0, 0);
  STAGE8(SB8(0, 1), Bt, ldb, 128, 0); STAGE8(SA8(0, 1), A, lda, 128, 0);
  if (wr == 1) BAR8;
  WAITV8(4); BAR8;
  STAGE8(SB8(1, 0), Bt, ldb, 0, 1); STAGE8(SA8(1, 0), A, lda, 0, 1); STAGE8(SB8(1, 1), Bt, ldb, 128, 1);
  WAITV8(6); BAR8;
  for (int t = 0; t < nt - 2; t += 2) {
    LDB8(B0, 0, 0); SCHED8; LDA8(At, 0, 0); STAGE8(SA8(1, 1), A, lda, 128, t + 1);
    WAITL8(8); BAR8; WAITL8(0); MMA8(0, 0, At, B0); BAR8; SCHED8;
    LDB8(B1, 0, 1); STAGE8(SB8(0, 0), Bt, ldb, 0, t + 2);
    BAR8; WAITL8(0); MMA8(0, 1, At, B1); BAR8;
    LDA8(At, 0, 1); STAGE8(SA8(0, 0), A, lda, 0, t + 2);
    BAR8; WAITL8(0); MMA8(1, 0, At, B0); BAR8; SCHED8;
    STAGE8(SB8(0, 1), Bt, ldb, 128, t + 2);
    WAITV8(6); BAR8; MMA8(1, 1, At, B1); BAR8;
    LDB8(B0, 1, 0); SCHED8; LDA8(At, 1, 0); STAGE8(SA8(0, 1), A, lda, 128, t + 2);
    WAITL8(8); BAR8; WAITL8(0); MMA8(0, 0, At, B0); BAR8; SCHED8;
    LDB8(B1, 1, 1); STAGE8(SB8(1, 0), Bt, ldb, 0, t + 3);
    BAR8; WAITL8(0); MMA8(0, 1, At, B1); BAR8;
    LDA8(At, 1, 1); STAGE8(SA8(1, 0), A, lda, 0, t + 3);
    BAR8; WAITL8(0); MMA8(1, 0, At, B0); BAR8; SCHED8;
    STAGE8(SB8(1, 1), Bt, ldb, 128, t + 3);
    WAITV8(6); BAR8; MMA8(1, 1, At, B1); BAR8;
  }
  {
    LDB8(B0, 0, 0); LDA8(At, 0, 0); STAGE8(SA8(1, 1), A, lda, 128, nt - 1);
    BAR8; WAITL8(0); MMA8(0, 0, At, B0); BAR8;
    LDB8(B1, 0, 1); BAR8; WAITL8(0); MMA8(0, 1, At, B1); BAR8;
    LDA8(At, 0, 1); WAITV8(4); BAR8; WAITL8(0); MMA8(1, 0, At, B0); MMA8(1, 1, At, B1); BAR8;
  }
  {
    LDB8(B0, 1, 0); LDA8(At, 1, 0); WAITV8(2); BAR8; WAITL8(0); MMA8(0, 0, At, B0); BAR8;
    LDB8(B1, 1, 1); WAITV8(0); BAR8; WAITL8(0); MMA8(0, 1, At, B1); BAR8;
    LDA8(At, 1, 1); BAR8; WAITL8(0); MMA8(1, 0, At, B0); MMA8(1, 1, At, B1); BAR8;
  }
  if (wr == 0) BAR8;
}

DI void unit_order(int L, int nM, int nN, int& pm, int& pn) {
  const int nwg = nM * nN;
  int wgid = L;
  { const int q = nwg / 8, r = nwg % 8, xcd = wgid % 8, off = wgid / 8; wgid = (xcd < r ? xcd * (q + 1) : r * (q + 1) + (xcd - r) * q) + off; }
  const int nig = 8 * nN, gid = wgid / nig, fm = gid * 8, gsz = (nM - fm) < 8 ? (nM - fm) : 8;
  pm = fm + ((wgid % nig) % gsz);
  pn = (wgid % nig) / gsz;
}

DI void epi_proj(const Params& p, int pm, int pn, f32x4 (&acc)[8][4]) {
  const int tid = otid(p.wv);
  const int wid = tid >> 6, lane = tid & 63, wr = wid >> 2, wc = wid & 3, fr = lane & 15, fq = lane >> 4;
  const int brow = pm * 256;
  const int b = brow >> 11;
  const int srow0 = (brow & 2047) + fq * 4;
  const int trow0 = brow + fq * 4;
  const float2* t128 = (const float2*)(p.ws + OFF_MISC + MISC_TAB128);
  const float2* t64 = (const float2*)(p.ws + OFF_MISC + MISC_TAB64);
  if (pn < 4) {
    bf16_t* qa = (bf16_t*)(p.ws + OFF_QA);
    const int head = pn * 2 + (wc >> 1), w = wc & 1;
    const float sc = 0.08838834764831845f * LOG2E;
#pragma unroll
    for (int m = 0; m < 8; ++m) {
      float2 cs[4][2];
#pragma unroll
      for (int j = 0; j < 4; ++j)
#pragma unroll
        for (int n = 0; n < 2; ++n) cs[j][n] = t128[(srow0 + ROWM(m) + j) * 64 + 32 * w + 16 * n + fr];
#pragma unroll
      for (int j = 0; j < 4; ++j) {
        size_t tk = (size_t)(trow0 + ROWM(m) + j);
#pragma unroll
        for (int n = 0; n < 2; ++n) {
          int d1 = 32 * w + 16 * n + fr;
          float x1 = acc[m][n][j], x2 = acc[m][n + 2][j];
          qa[tk * 1024 + head * 128 + d1] = f2bf((x1 * cs[j][n].x - x2 * cs[j][n].y) * sc);
          qa[tk * 1024 + head * 128 + d1 + 64] = f2bf((x2 * cs[j][n].x + x1 * cs[j][n].y) * sc);
        }
      }
    }
  } else if (pn == 4 || pn == 6 || pn == 8) {
    bf16_t* kd = (bf16_t*)(p.ws + (pn == 4 ? OFF_KCA : (pn == 6 ? OFF_KSA : OFF_KWA)));
    const int h = wc >> 1, w = wc & 1;
#pragma unroll
    for (int m = 0; m < 8; ++m) {
      float2 cs[4][2];
#pragma unroll
      for (int j = 0; j < 4; ++j)
#pragma unroll
        for (int n = 0; n < 2; ++n) cs[j][n] = t128[(srow0 + ROWM(m) + j) * 64 + 32 * w + 16 * n + fr];
#pragma unroll
      for (int j = 0; j < 4; ++j) {
        int s = srow0 + ROWM(m) + j;
        size_t rb = ((size_t)(b * 2 + h) * 2048 + s) * 128;
#pragma unroll
        for (int n = 0; n < 2; ++n) {
          int d1 = 32 * w + 16 * n + fr;
          float x1 = acc[m][n][j], x2 = acc[m][n + 2][j];
          kd[rb + d1] = f2bf(x1 * cs[j][n].x - x2 * cs[j][n].y);
          kd[rb + d1 + 64] = f2bf(x2 * cs[j][n].x + x1 * cs[j][n].y);
        }
      }
    }
  } else if (pn == 5) {
    bf16_t* vd = (bf16_t*)(p.ws + OFF_VCA);
    const int h = wc >> 1, w = wc & 1;
#pragma unroll
    for (int m = 0; m < 8; ++m)
#pragma unroll
      for (int j = 0; j < 4; ++j) {
        int s = srow0 + ROWM(m) + j;
        size_t rb = ((size_t)(b * 2 + h) * 2048 + s) * 128;
#pragma unroll
        for (int n = 0; n < 4; ++n) vd[rb + w * 64 + n * 16 + fr] = f2bf(acc[m][n][j]);
      }
  } else if (pn == 7 || pn == 9) {
    bf16_t* vd = (bf16_t*)(p.ws + (pn == 7 ? OFF_VSAT : OFF_VWAT));
    const int h = wc >> 1, w = wc & 1;
#pragma unroll
    for (int m = 0; m < 8; ++m) {
      int s0 = srow0 + ROWM(m);
#pragma unroll
      for (int n = 0; n < 4; ++n) {
        int d = w * 64 + n * 16 + fr;
        uint2 o;
        o.x = pack2(acc[m][n][0], acc[m][n][1]);
        o.y = pack2(acc[m][n][2], acc[m][n][3]);
        *(uint2*)(vd + ((size_t)(b * 2 + h) * 128 + d) * 2048 + s0) = o;
      }
    }
  } else if ((pn >= 10 && pn < 14) || (pn >= 19 && pn < 23)) {
    bf16_t* zd = (bf16_t*)(p.ws + (pn < 14 ? OFF_ZA : OFF_ZB));
    const int cb = (pn < 14 ? (pn - 10) : (pn - 19)) * 256 + wc * 64;
#pragma unroll
    for (int m = 0; m < 8; ++m)
#pragma unroll
      for (int j = 0; j < 4; ++j) {
        size_t tk = (size_t)(trow0 + ROWM(m) + j);
#pragma unroll
        for (int n = 0; n < 4; ++n) zd[tk * 1024 + cb + n * 16 + fr] = f2bf(silu_f(acc[m][n][j]));
      }
  } else if (pn >= 14 && pn < 18) {
    bf16_t* qb = (bf16_t*)(p.ws + OFF_QB);
    const int head = (pn - 14) * 4 + wc;
    const float sc = 0.125f * LOG2E;
#pragma unroll
    for (int m = 0; m < 8; ++m) {
      float2 cs[4][2];
#pragma unroll
      for (int j = 0; j < 4; ++j)
#pragma unroll
        for (int n = 0; n < 2; ++n) cs[j][n] = t64[(srow0 + ROWM(m) + j) * 32 + 16 * n + fr];
#pragma unroll
      for (int j = 0; j < 4; ++j) {
        size_t tk = (size_t)(trow0 + ROWM(m) + j);
#pragma unroll
        for (int n = 0; n < 2; ++n) {
          int d1 = 16 * n + fr;
          float x1 = acc[m][n][j], x2 = acc[m][n + 2][j];
          qb[tk * 1024 + head * 64 + d1] = f2bf((x1 * cs[j][n].x - x2 * cs[j][n].y) * sc);
          qb[tk * 1024 + head * 64 + d1 + 32] = f2bf((x2 * cs[j][n].x + x1 * cs[j][n].y) * sc);
        }
      }
    }
  } else if (pn == 18) {
    if (wc < 2) {
      bf16_t* kd = (bf16_t*)(p.ws + OFF_KB);
      const int h = wc;
#pragma unroll
      for (int m = 0; m < 8; ++m) {
        float2 cs[4][2];
#pragma unroll
        for (int j = 0; j < 4; ++j)
#pragma unroll
          for (int n = 0; n < 2; ++n) cs[j][n] = t64[(srow0 + ROWM(m) + j) * 32 + 16 * n + fr];
#pragma unroll
        for (int j = 0; j < 4; ++j) {
          int s = srow0 + ROWM(m) + j;
          size_t rb = ((size_t)(b * 2 + h) * 2048 + s) * 64;
#pragma unroll
          for (int n = 0; n < 2; ++n) {
            int d1 = 16 * n + fr;
            float x1 = acc[m][n][j], x2 = acc[m][n + 2][j];
            kd[rb + d1] = f2bf(x1 * cs[j][n].x - x2 * cs[j][n].y);
            kd[rb + d1 + 32] = f2bf(x2 * cs[j][n].x + x1 * cs[j][n].y);
          }
        }
      }
    } else {
      bf16_t* vd = (bf16_t*)(p.ws + OFF_VBT);
      const int h = wc - 2;
#pragma unroll
      for (int m = 0; m < 8; ++m) {
        int s0 = srow0 + ROWM(m);
#pragma unroll
        for (int n = 0; n < 4; ++n) {
          int d = n * 16 + fr;
          uint2 o;
          o.x = pack2(acc[m][n][0], acc[m][n][1]);
          o.y = pack2(acc[m][n][2], acc[m][n][3]);
          *(uint2*)(vd + ((size_t)(b * 2 + h) * 64 + d) * 2048 + s0) = o;
        }
      }
    }
  } else {
    if (wc == 0) {
      float* gd = (float*)(p.ws + OFF_GATES);
#pragma unroll
      for (int m = 0; m < 8; ++m)
#pragma unroll
        for (int j = 0; j < 4; ++j) {
          size_t tk = (size_t)(trow0 + ROWM(m) + j);
#pragma unroll
          for (int n = 0; n < 2; ++n) {
            int c = n * 16 + fr;
            if (c < 24) gd[tk * 24 + c] = sigmoid_f(acc[m][n][j]);
          }
        }
    }
  }
}

DI void phase_proj(const Params& p) {
  const bf16_t* hb = (const bf16_t*)(p.ws + OFF_HB);
  const bf16_t* wtin = (const bf16_t*)(p.ws + OFF_WTIN);
  for (int L = blockIdx.x; L < 64 * 24; L += gridDim.x) {
    int pm, pn;
    unit_order(L, 64, 24, pm, pn);
    f32x4 acc[8][4];
    if (pn == 23) gemm_mainloop8<false, true>(p.wv, hb + (size_t)pm * 256 * DM, DM, wtin + (size_t)pn * 256 * DM, DM, DM / 64, acc, (p.wv & 3) == 0);
    else gemm_mainloop8<false, false>(p.wv, hb + (size_t)pm * 256 * DM, DM, wtin + (size_t)pn * 256 * DM, DM, DM / 64, acc);
    epi_proj(p, pm, pn, acc);
  }
}

template <int ROWS, int D>
DI void load_rows_tile(const bf16_t* __restrict__ src, char* dst, int tid) {
  constexpr int KSTR = D * 2 + 16, CH = D / 8, NI = ROWS * CH / NTHR;
  u32x4 v[NI];
#pragma unroll
  for (int i = 0; i < NI; ++i) v[i] = *(const u32x4*)(src + (tid + i * NTHR) * 8);
#pragma unroll
  for (int i = 0; i < NI; ++i) {
    const int idx = tid + i * NTHR;
    *(u32x4*)(dst + (idx / CH) * KSTR + (idx % CH) * 16) = v[i];
  }
}
template <int D, int NKEY>
DI void load_vt_tile(const bf16_t* __restrict__ srcT, int gstride, char* dst, int tid) {
  constexpr int VSTR = NKEY * 2 + 8, CH = NKEY / 8, NI = D * CH / NTHR;
  u32x4 v[NI];
#pragma unroll
  for (int i = 0; i < NI; ++i) {
    const int idx = tid + i * NTHR;
    v[i] = *(const u32x4*)(srcT + (size_t)(idx / CH) * gstride + (idx % CH) * 8);
  }
#pragma unroll
  for (int i = 0; i < NI; ++i) {
    const int idx = tid + i * NTHR;
    uint2* q = (uint2*)(dst + (idx / CH) * VSTR + (idx % CH) * 16);
    q[0] = make_uint2(v[i][0], v[i][1]);
    q[1] = make_uint2(v[i][2], v[i][3]);
  }
}
DI bf16x8 pack8(const f32x16& x, int s) {
  union { unsigned u[4]; bf16x8 v; } t;
#pragma unroll
  for (int q = 0; q < 4; ++q) t.u[q] = pack2(x[8 * s + 2 * q], x[8 * s + 2 * q + 1]);
  return t.v;
}
DI bf16x8 lds_vfrag(const char* pv) {
  union { uint2 u[2]; bf16x8 v; } t;
  t.u[0] = *(const uint2*)(pv);
  t.u[1] = *(const uint2*)(pv + 16);
  return t.v;
}

template <int D, class VF>
DI void attn_subtile(const char* Ks, const char* Vt, int vstr, const bf16x8* Qf, f32x16* O, float& m, float& l, int r, int hh, VF valid) {
  constexpr int KSTR = D * 2 + 16;
  f32x16 S;
#pragma unroll
  for (int i = 0; i < 16; ++i) S[i] = 0.f;
#pragma unroll
  for (int ks = 0; ks < D / 16; ++ks) {
    bf16x8 kf = *(const bf16x8*)(Ks + r * KSTR + (ks * 16 + hh * 8) * 2);
    S = MFMA32(kf, Qf[ks], S);
  }
  float mx = -1e30f;
#pragma unroll
  for (int i = 0; i < 16; ++i) {
    bool ok = valid(crow(i, hh));
    S[i] = ok ? S[i] : -1e30f;
    mx = fmaxf(mx, S[i]);
  }
  mx = fmaxf(mx, __shfl_xor(mx, 32));
  float mnew = fmaxf(m, mx);
  float alpha = ex2(m - mnew);
  float ps = 0.f;
#pragma unroll
  for (int i = 0; i < 16; ++i) {
    float pv = (S[i] > -1e29f) ? ex2(S[i] - mnew) : 0.f;
    ps += pv;
    S[i] = pv;
  }
  ps += __shfl_xor(ps, 32);
  l = l * alpha + ps;
  m = mnew;
#pragma unroll
  for (int dt = 0; dt < D / 32; ++dt)
#pragma unroll
    for (int i = 0; i < 16; ++i) O[dt][i] *= alpha;
  bf16x8 pf0 = pack8(S, 0), pf1 = pack8(S, 1);
#pragma unroll
  for (int dt = 0; dt < D / 32; ++dt) {
    const char* vrow = Vt + (dt * 32 + r) * vstr + hh * 8;
    bf16x8 v0 = lds_vfrag(vrow);
    bf16x8 v1 = lds_vfrag(vrow + 32);
    O[dt] = MFMA32(v0, pf0, O[dt]);
    O[dt] = MFMA32(v1, pf1, O[dt]);
  }
}

struct PFrag { bf16x8 a0, a1, b0, b1; };
template <int D, class VF>
DI void attn_scores(const char* Ks, const bf16x8* Qf, f32x16* O, float& m, float& l, int r, int hh, bool colsel, bool masked,
                    bool first, VF valid, PFrag& P) {
  constexpr int KSTR = D * 2 + 16;
  f32x16 S0, S1;
#pragma unroll
  for (int i = 0; i < 16; ++i) { S0[i] = 0.f; S1[i] = 0.f; }
  __builtin_amdgcn_s_setprio(1);
#pragma unroll
  for (int ks = 0; ks < D / 16; ++ks) {
    bf16x8 k0 = *(const bf16x8*)(Ks + r * KSTR + (ks * 16 + hh * 8) * 2);
    bf16x8 k1 = *(const bf16x8*)(Ks + (32 + r) * KSTR + (ks * 16 + hh * 8) * 2);
    S0 = MFMA32(k0, Qf[ks], S0);
    S1 = MFMA32(k1, Qf[ks], S1);
  }
  __builtin_amdgcn_s_setprio(0);
  if (masked) {
#pragma unroll
    for (int i = 0; i < 16; ++i) {
      S0[i] = valid(crow(i, hh)) ? S0[i] : -1e30f;
      S1[i] = valid(32 + crow(i, hh)) ? S1[i] : -1e30f;
    }
  }
  if (first || __builtin_amdgcn_ballot_w64(m < -1e29f) != 0ull) {
    float mx = -1e30f;
#pragma unroll
    for (int i = 0; i < 16; ++i) mx = fmaxf(mx, fmaxf(S0[i], S1[i]));
    if (!colsel) mx = -1e30f;
    mx = fmaxf(mx, xhalf(mx, r, hh));
    if (first || m < -1e29f) {
      const float mnew = fmaxf(m, mx);
      l *= ex2(m - mnew);
      m = mnew;
    }
  }
  const float moff = (colsel && m > -1e29f) ? m : 1e30f;
  float ps = 0.f;
#pragma unroll
  for (int i = 0; i < 16; ++i) {
    float p0 = ex2(S0[i] - moff), p1 = ex2(S1[i] - moff);
    ps += p0 + p1;
    S0[i] = p0;
    S1[i] = p1;
  }
  if (__builtin_amdgcn_ballot_w64(ps > 4096.f) != 0ull) {
    const float ps2 = ps + xhalf(ps, r, hh);
    const int e = ps2 > 4096.f ? (int)((__float_as_uint(ps2) >> 23) & 0xffu) - 127 : 0;
    const float sc = __uint_as_float((unsigned)(127 - e) << 23);
    m += (float)e;
    l *= sc;
    ps *= sc;
#pragma unroll
    for (int i = 0; i < 16; ++i) { S0[i] *= sc; S1[i] *= sc; }
#pragma unroll
    for (int dt = 0; dt < D / 32; ++dt)
#pragma unroll
      for (int i = 0; i < 16; ++i) O[dt][i] *= sc;
  }
  l += ps;
  P.a0 = pack8(S0, 0);
  P.a1 = pack8(S0, 1);
  P.b0 = pack8(S1, 0);
  P.b1 = pack8(S1, 1);
}

template <int D>
DI void attn_pv(const char* Vs, f32x16* O, const PFrag& P, int r, int hh) {
  __builtin_amdgcn_s_setprio(1);
#pragma unroll
  for (int dt = 0; dt < D / 32; ++dt) {
    const char* vrow = Vs + (dt * 32 + r) * 144 + hh * 16;
    bf16x8 v0 = *(const bf16x8*)(vrow);
    bf16x8 v1 = *(const bf16x8*)(vrow + 32);
    bf16x8 v2 = *(const bf16x8*)(vrow + 64);
    bf16x8 v3 = *(const bf16x8*)(vrow + 96);
    O[dt] = MFMA32(v0, P.a0, O[dt]);
    O[dt] = MFMA32(v1, P.a1, O[dt]);
    O[dt] = MFMA32(v2, P.b0, O[dt]);
    O[dt] = MFMA32(v3, P.b1, O[dt]);
  }
  __builtin_amdgcn_s_setprio(0);
}

DI void wave_lds_fence() {
  __builtin_amdgcn_fence(__ATOMIC_RELEASE, "wavefront");
  __builtin_amdgcn_wave_barrier();
  __builtin_amdgcn_fence(__ATOMIC_ACQUIRE, "wavefront");
}
template <int G, int ROWB, int NT>
DI void wtile_load(const bf16_t* __restrict__ g0, size_t tstride, char* lw, int lane) {
  u32x4 v[NT];
#pragma unroll
  for (int i = 0; i < NT; ++i) v[i] = __builtin_nontemporal_load((const u32x4*)(g0 + (size_t)i * tstride + lane * 8));
  wave_lds_fence();
#pragma unroll
  for (int i = 0; i < NT; ++i) {
    uint2* q = (uint2*)(lw + (i * G + (lane * 16) / ROWB) * (ROWB + 8) + (lane * 16) % ROWB);
    q[0] = make_uint2(v[i][0], v[i][1]);
    q[1] = make_uint2(v[i][2], v[i][3]);
  }
  wave_lds_fence();
}
template <int G, int ROWB, int NT>
DI void wtile_store(bf16_t* __restrict__ g0, size_t tstride, const char* lw, int lane) {
  wave_lds_fence();
#pragma unroll
  for (int i = 0; i < NT; ++i) {
    const uint2* q = (const uint2*)(lw + (i * G + (lane * 16) / ROWB) * (ROWB + 8) + (lane * 16) % ROWB);
    uint2 a = q[0], b2 = q[1];
    u32x4 v = {a.x, a.y, b2.x, b2.y};
    *(u32x4*)(g0 + (size_t)i * tstride + lane * 8) = v;
  }
}

template <int D>
struct KVPrefetch {
  static constexpr int NC = (64 * D / 8) / NTHR;
  u32x4 k0, k1, v0, v1;
  DI void issue(const bf16_t* __restrict__ ksrc, const bf16_t* __restrict__ vsrcT, int tid) {
    k0 = *(const u32x4*)(ksrc + tid * 8);
    v0 = *(const u32x4*)(vsrcT + (size_t)(tid >> 3) * 2048 + (tid & 7) * 8);
    if constexpr (NC > 1) {
      const int idx = tid + NTHR;
      k1 = *(const u32x4*)(ksrc + idx * 8);
      v1 = *(const u32x4*)(vsrcT + (size_t)(idx >> 3) * 2048 + (idx & 7) * 8);
    }
  }
  DI void commit(char* Ks, char* Vs, int tid) {
    constexpr int KSTR = D * 2 + 16, CH = D / 8;
    {
      *(u32x4*)(Ks + (tid / CH) * KSTR + (tid % CH) * 16) = k0;
      char* q = Vs + (tid >> 3) * 144 + ((tid & 7) >> 1) * 32 + (tid & 1) * 8;
      *(uint2*)q = make_uint2(v0.x, v0.y);
      *(uint2*)(q + 16) = make_uint2(v0.z, v0.w);
    }
    if constexpr (NC > 1) {
      const int idx = tid + NTHR;
      *(u32x4*)(Ks + (idx / CH) * KSTR + (idx % CH) * 16) = k1;
      char* q = Vs + (idx >> 3) * 144 + ((idx & 7) >> 1) * 32 + (idx & 1) * 8;
      *(uint2*)q = make_uint2(v1.x, v1.y);
      *(uint2*)(q + 16) = make_uint2(v1.z, v1.w);
    }
  }
};

DI int next_item(int wv, int* ctr) {
  int* sl = (int*)(g_shm + SHM_BYTES - 16);
  __syncthreads();
  if (otid(wv) == 0) *sl = atomicAdd(ctr, 1);
  __syncthreads();
  int v = *sl;
  return v;
}

DI void item_compress_part(const Params& p, int mat, int mt, int ks) {
  const bf16_t* A = (const bf16_t*)(p.ws + (mat ? OFF_VCA : OFF_KCA)) + (size_t)mt * 256 * 2048 + ks * 1024;
  const bf16_t* w1t = (const bf16_t*)(p.ws + OFF_W1T) + (size_t)mat * 256 * 4096 + ks * 1024;
  f32x4 acc[8][4];
  gemm_mainloop8<false>(p.wv, A, 2048, w1t, 4096, 1024 / 64, acc);
  const int tid = otid(p.wv), wid = tid >> 6, lane = tid & 63, wr = wid >> 2, wc = wid & 3, fr = lane & 15, fq = lane >> 4;
  float* part = (float*)(p.ws + OFF_CPART) + ((size_t)(mat * 4 + ks) * 2048 + mt * 256) * 256;
#pragma unroll
  for (int m = 0; m < 8; ++m)
#pragma unroll
    for (int n = 0; n < 4; ++n)
#pragma unroll
      for (int j = 0; j < 4; ++j) part[(size_t)(ROWM(m) + fq * 4 + j) * 256 + COLN(n) + fr] = acc[m][n][j];
  asm volatile("s_waitcnt vmcnt(0)" ::: "memory");
  __syncthreads();
  if (tid == 0) {
    __builtin_amdgcn_fence(__ATOMIC_RELEASE, "agent");
    asm volatile("s_waitcnt vmcnt(0)" ::: "memory");
    __hip_atomic_fetch_add((unsigned*)(p.ws + OFF_MISC + MISC_CTR) + 256 + mat * 8 + mt, 1u, __ATOMIC_RELAXED, __HIP_MEMORY_SCOPE_AGENT);
  }
}

DI void item_compress_fin(const Params& p, int mat, int rb) {
  const int tid = otid(p.wv), wid = tid >> 6, lane = tid & 63;
  const bf16_t* w2t = (const bf16_t*)(p.ws + OFF_W2T) + (size_t)mat * 128 * 256;
  const float* biasp = (const float*)(p.ws + OFF_MISC + MISC_BIASP) + mat * 16 * 256;
  const float* part = (const float*)(p.ws + OFF_CPART) + (size_t)(mat * 4) * 2048 * 256;
  constexpr int HSTR = 528;
  const int R0 = rb * 64;
  __syncthreads();
  {
    const int c4 = (tid & 63) * 4, rq = tid >> 6;
    f32x4 bias = {0.f, 0.f, 0.f, 0.f};
#pragma unroll
    for (int ch = 0; ch < 16; ++ch) bias += *(const f32x4*)(biasp + ch * 256 + c4);
#pragma unroll
    for (int i = 0; i < 8; ++i) {
      const int row = rq + 8 * i;
      f32x4 a = bias;
#pragma unroll
      for (int ks = 0; ks < 4; ++ks) a += *(const f32x4*)(part + ((size_t)ks * 2048 + R0 + row) * 256 + c4);
      uint2 o;
      o.x = pack2(silu_f(a[0]), silu_f(a[1]));
      o.y = pack2(silu_f(a[2]), silu_f(a[3]));
      *(uint2*)(g_shm + row * HSTR + c4 * 2) = o;
    }
  }
  __syncthreads();
  {
    const int r = lane & 31, hh = lane >> 5;
    const int rh = wid & 1, ct = wid >> 1;
    f32x16 C;
#pragma unroll
    for (int i = 0; i < 16; ++i) C[i] = 0.f;
#pragma unroll 4
    for (int ks = 0; ks < 16; ++ks) {
      bf16x8 hf = *(const bf16x8*)(g_shm + (rh * 32 + r) * HSTR + (ks * 16 + hh * 8) * 2);
      bf16x8 wf = *(const bf16x8*)(w2t + (size_t)(ct * 32 + r) * 256 + ks * 16 + hh * 8);
      if (mat == 0) C = MFMA32(wf, hf, C);
      else C = MFMA32(hf, wf, C);
    }
    if (mat == 0) {
      bf16_t* kc = (bf16_t*)(p.ws + OFF_KC);
      size_t R = (size_t)R0 + rh * 32 + r;
#pragma unroll
      for (int g = 0; g < 4; ++g) {
        uint2 o;
        o.x = pack2(C[4 * g], C[4 * g + 1]);
        o.y = pack2(C[4 * g + 2], C[4 * g + 3]);
        *(uint2*)(kc + R * 128 + ct * 32 + 8 * g + 4 * hh) = o;
      }
    } else {
      bf16_t* vct = (bf16_t*)(p.ws + OFF_VCT);
#pragma unroll
      for (int g = 0; g < 4; ++g) {
        int Rr = R0 + rh * 32 + 8 * g + 4 * hh;
        int bh = Rr >> 7, c0 = Rr & 127;
        uint2 o;
        o.x = pack2(C[4 * g], C[4 * g + 1]);
        o.y = pack2(C[4 * g + 2], C[4 * g + 3]);
        *(uint2*)(vct + ((size_t)bh * 128 + ct * 32 + r) * 128 + c0) = o;
      }
    }
  }
}

DI void phase_cmp2(const Params& p) {
  for (int it = blockIdx.x; it < 64; it += gridDim.x) item_compress_fin(p, it >> 5, it & 31);
}

DI void item_win_a(const Params& p, int b, int h, int qb) {
  const int tid = otid(p.wv);
  const int wid = tid >> 6, lane = tid & 63, r = lane & 31, hh = lane >> 5;
  const int q0 = qb * 64;
  const int t = q0 + wid * 8 + (r >> 2);
  const int head = h * 4 + (r & 3);
  const bf16_t* qa = (const bf16_t*)(p.ws + OFF_QA) + ((size_t)(b * 2048 + t) * 1024 + head * 128);
  const bf16_t* kw = (const bf16_t*)(p.ws + OFF_KWA) + (size_t)(b * 2 + h) * 2048 * 128;
  const bf16_t* vt = (const bf16_t*)(p.ws + OFF_VWAT) + (size_t)(b * 2 + h) * 128 * 2048;
  bf16x8 Qf[8];
#pragma unroll
  for (int ks = 0; ks < 8; ++ks) Qf[ks] = *(const bf16x8*)(qa + ks * 16 + hh * 8);
  f32x16 O[4];
#pragma unroll
  for (int dt = 0; dt < 4; ++dt)
#pragma unroll
    for (int i = 0; i < 16; ++i) O[dt][i] = 0.f;
  float m = -1e30f, l = 0.f;
  const int tw0 = q0 + wid * 8, tw1 = tw0 + 7;
  int kt0 = qb - 8 < 0 ? 0 : qb - 8;
  {
    KVPrefetch<128> pf;
    pf.issue(kw + (size_t)kt0 * 64 * 128, vt + kt0 * 64, tid);
    __syncthreads();
    pf.commit(g_shm, g_shm + 34816, tid);
    if (kt0 + 1 <= qb) pf.issue(kw + (size_t)(kt0 + 1) * 64 * 128, vt + (kt0 + 1) * 64, tid);
    __syncthreads();
    const bool late = p.wv >= 4;
    PFrag Pc;
    bool have = false;
    int vprev = 0;
    for (int kt = kt0; kt <= qb; ++kt) {
      const int j = kt - kt0, cur = j & 1, vc = j % 3;
      if (late && have) { attn_pv<128>(g_shm + 34816 + vprev * 18432, O, Pc, r, hh); have = false; }
      {
        const int key0 = kt * 64;
        if (key0 <= tw1 && key0 + 63 > tw0 - 512) {
          auto vf = [&](int kl) { int key = key0 + kl; return key <= t && t - key < 512; };
          const bool masked = !(key0 + 63 <= tw0 && tw1 - key0 < 512);
          PFrag Pn;
          attn_scores<128>(g_shm + cur * 17408, Qf, O, m, l, r, hh, true, masked, kt == kt0, vf, Pn);
          if (late) { Pc = Pn; have = true; vprev = vc; }
          else attn_pv<128>(g_shm + 34816 + vc * 18432, O, Pn, r, hh);
        }
      }
      if (kt + 1 <= qb) {
        pf.commit(g_shm + (cur ^ 1) * 17408, g_shm + 34816 + ((vc + 1) % 3) * 18432, tid);
        if (kt + 2 <= qb) pf.issue(kw + (size_t)(kt + 2) * 64 * 128, vt + (kt + 2) * 64, tid);
      }
      __syncthreads();
    }
    if (late && have) attn_pv<128>(g_shm + 34816 + vprev * 18432, O, Pc, r, hh);
    __syncthreads();
  }
  l += xhalf(l, r, hh);
  float inv = 1.f / fmaxf(l, 1e-30f);
  char* lw = g_shm + wid * 8448;
#pragma unroll
  for (int dt = 0; dt < 4; ++dt)
#pragma unroll
    for (int g = 0; g < 4; ++g) {
      uint2 o;
      o.x = pack2(O[dt][4 * g] * inv, O[dt][4 * g + 1] * inv);
      o.y = pack2(O[dt][4 * g + 2] * inv, O[dt][4 * g + 3] * inv);
      *(uint2*)(lw + r * 264 + (dt * 32 + 8 * g + 4 * hh) * 2) = o;
    }
  wtile_store<4, 256, 8>((bf16_t*)(p.ws + OFF_OWIN) + (size_t)(b * 2048 + q0 + wid * 8) * 1024 + h * 512, 1024, lw, lane);
}

DI void item_attn_b(const Params& p, int b, int h, int qb) {
  const int tid = otid(p.wv);
  const int wid = tid >> 6, lane = tid & 63, r = lane & 31, hh = lane >> 5;
  const int q0 = qb * 32;
  const int t = q0 + wid * 4 + (r >> 3);
  const int head = h * 8 + (r & 7);
  const bf16_t* qp = (const bf16_t*)(p.ws + OFF_QB) + ((size_t)(b * 2048 + t) * 1024 + head * 64);
  const bf16_t* kb = (const bf16_t*)(p.ws + OFF_KB) + (size_t)(b * 2 + h) * 2048 * 64;
  const bf16_t* vt = (const bf16_t*)(p.ws + OFF_VBT) + (size_t)(b * 2 + h) * 64 * 2048;
  bf16x8 Qf[4];
#pragma unroll
  for (int ks = 0; ks < 4; ++ks) Qf[ks] = *(const bf16x8*)(qp + ks * 16 + hh * 8);
  f32x16 O[2];
#pragma unroll
  for (int dt = 0; dt < 2; ++dt)
#pragma unroll
    for (int i = 0; i < 16; ++i) O[dt][i] = 0.f;
  float m = p.sinks[head] * LOG2E, l = hh == 0 ? 1.f : 0.f;
  const int tw0 = q0 + wid * 4, tw1 = tw0 + 3;
  int kt0 = (q0 - 127) < 0 ? 0 : ((q0 - 127) >> 6);
  int kt1 = (q0 + 31) >> 6;
  {
    KVPrefetch<64> pf;
    pf.issue(kb + (size_t)kt0 * 64 * 64, vt + kt0 * 64, tid);
    __syncthreads();
    pf.commit(g_shm, g_shm + 34816, tid);
    if (kt0 + 1 <= kt1) pf.issue(kb + (size_t)(kt0 + 1) * 64 * 64, vt + (kt0 + 1) * 64, tid);
    __syncthreads();
    const bool late = p.wv >= 4;
    PFrag Pc;
    bool have = false;
    int vprev = 0;
    for (int kt = kt0; kt <= kt1; ++kt) {
      const int j = kt - kt0, cur = j & 1, vc = j % 3;
      if (late && have) { attn_pv<64>(g_shm + 34816 + vprev * 18432, O, Pc, r, hh); have = false; }
      {
        const int key0 = kt * 64;
        if (key0 <= tw1 && key0 + 63 > tw0 - 128) {
          auto vf = [&](int kl) { int key = key0 + kl; return key <= t && t - key < 128; };
          const bool masked = !(key0 + 63 <= tw0 && tw1 - key0 < 128);
          PFrag Pn;
          attn_scores<64>(g_shm + cur * 17408, Qf, O, m, l, r, hh, true, masked, kt == kt0, vf, Pn);
          if (late) { Pc = Pn; have = true; vprev = vc; }
          else attn_pv<64>(g_shm + 34816 + vc * 18432, O, Pn, r, hh);
        }
      }
      if (kt + 1 <= kt1) {
        pf.commit(g_shm + (cur ^ 1) * 17408, g_shm + 34816 + ((vc + 1) % 3) * 18432, tid);
        if (kt + 2 <= kt1) pf.issue(kb + (size_t)(kt + 2) * 64 * 64, vt + (kt + 2) * 64, tid);
      }
      __syncthreads();
    }
    if (late && have) attn_pv<64>(g_shm + 34816 + vprev * 18432, O, Pc, r, hh);
    __syncthreads();
  }
  l += xhalf(l, r, hh);
  float inv = 1.f / fmaxf(l, 1e-30f);
  char* lw = g_shm + wid * 4352;
  const size_t tok0 = (size_t)(b * 2048 + q0 + wid * 4);
  wtile_load<8, 128, 4>((const bf16_t*)(p.ws + OFF_ZB) + tok0 * 1024 + h * 512, 1024, lw, lane);
  uint2 zr[2][4];
#pragma unroll
  for (int dt = 0; dt < 2; ++dt)
#pragma unroll
    for (int g = 0; g < 4; ++g) zr[dt][g] = *(const uint2*)(lw + r * 136 + (dt * 32 + 8 * g + 4 * hh) * 2);
#pragma unroll
  for (int dt = 0; dt < 2; ++dt)
#pragma unroll
    for (int g = 0; g < 4; ++g) {
      uint2 z = zr[dt][g];
      float z0 = __uint_as_float(z.x << 16), z1 = __uint_as_float(z.x & 0xffff0000u), z2 = __uint_as_float(z.y << 16), z3 = __uint_as_float(z.y & 0xffff0000u);
      uint2 o;
      o.x = pack2(O[dt][4 * g] * inv * z0, O[dt][4 * g + 1] * inv * z1);
      o.y = pack2(O[dt][4 * g + 2] * inv * z2, O[dt][4 * g + 3] * inv * z3);
      *(uint2*)(lw + r * 136 + (dt * 32 + 8 * g + 4 * hh) * 2) = o;
    }
  wtile_store<8, 128, 4>((bf16_t*)(p.ws + OFF_Y) + tok0 * 2048 + 1024 + h * 512, 2048, lw, lane);
}

DI void phase_mix1(const Params& p) {
  int* ctr = (int*)(p.ws + OFF_MISC + MISC_CTR);
  constexpr int N_CMP = 64, N_WA = 8 * 2 * 32, N_FIN = 64, N_B = 8 * 2 * 64;
  int* sl = (int*)(g_shm + SHM_BYTES - 16);
  int it = next_item(p.wv, ctr);
  for (;;) {
    if (it >= N_CMP + N_WA + N_FIN + N_B) break;
    int nxt = 0;
    const bool leader = otid(p.wv) == 0;
    if (leader) nxt = atomicAdd(ctr, 1);
    if (it < N_CMP) item_compress_part(p, it >> 5, (it >> 2) & 7, it & 3);
    else if (it < N_CMP + N_WA) { int i2 = it - N_CMP; int qb = 31 - (i2 >> 4), bh = i2 & 15; item_win_a(p, bh >> 1, bh & 1, qb); }
    else if (it < N_CMP + N_WA + N_FIN) {
      const int i2 = it - N_CMP - N_WA, mat = i2 >> 5, rb = i2 & 31;
      if (leader) {
        unsigned* cd = (unsigned*)(p.ws + OFF_MISC + MISC_CTR) + 256 + mat * 8 + (rb >> 2);
        unsigned sp = 0;
        while (__hip_atomic_load(cd, __ATOMIC_RELAXED, __HIP_MEMORY_SCOPE_AGENT) < 4u) {
          __builtin_amdgcn_s_sleep(4);
          if (++sp > (1u << 22)) break;
        }
        __builtin_amdgcn_fence(__ATOMIC_ACQUIRE, "agent");
        asm volatile("s_waitcnt vmcnt(0)" ::: "memory");
      }
      __syncthreads();
      item_compress_fin(p, mat, rb);
    }
    else { int i2 = it - N_CMP - N_WA - N_FIN; int qb = i2 >> 4, bh = i2 & 15; item_attn_b(p, bh >> 1, bh & 1, qb); }
    __syncthreads();
    if (leader) *sl = nxt;
    __syncthreads();
    it = *sl;
  }
}

DI void item_nsa(const Params& p, int b, int h, int qb) {
  const int tid = otid(p.wv);
  const int wid = tid >> 6, lane = tid & 63, r = lane & 31, hh = lane >> 5;
  const int q0 = qb * 64;
  const int tokl = wid * 8 + (r >> 2);
  const int t = q0 + tokl;
  const int head = h * 4 + (r & 3);
  const bf16_t* qa = (const bf16_t*)(p.ws + OFF_QA) + ((size_t)(b * 2048 + t) * 1024 + head * 128);
  bf16x8 Qf[8];
#pragma unroll
  for (int ks = 0; ks < 8; ++ks) Qf[ks] = *(const bf16x8*)(qa + ks * 16 + hh * 8);
  char* KcL = g_shm;
  char* VcL = g_shm + 34816;
  float* psum = (float*)(g_shm + 68608);
  float* scs = (float*)(g_shm + 101632);
  unsigned* smask = (unsigned*)(g_shm + 110080);
  char* OcL = g_shm;
  KVPrefetch<128> pf;
  pf.issue((const bf16_t*)(p.ws + OFF_KSA) + (size_t)(b * 2 + h) * 2048 * 128, (const bf16_t*)(p.ws + OFF_VSAT) + (size_t)(b * 2 + h) * 128 * 2048, tid);
  __syncthreads();
  load_rows_tile<128, 128>((const bf16_t*)(p.ws + OFF_KC) + (size_t)(b * 2 + h) * 128 * 128, KcL, tid);
  load_vt_tile<128, 128>((const bf16_t*)(p.ws + OFF_VCT) + (size_t)(b * 2 + h) * 128 * 128, 128, VcL, tid);
  __syncthreads();
  f32x16 Oc[4];
  {
    f32x16 S[4];
    const int cmax = t >= 31 ? ((t - 31) >> 4) : -1;
    const int tlast = q0 + p.wv * 8 + 7;
    const int cmax_w = tlast >= 31 ? ((tlast - 31) >> 4) : -1;
    float mx = -1e30f;
#pragma unroll
    for (int sub = 0; sub < 4; ++sub) {
      if (sub * 32 <= cmax_w) {
#pragma unroll
        for (int i = 0; i < 16; ++i) S[sub][i] = 0.f;
#pragma unroll
        for (int ks = 0; ks < 8; ++ks) {
          bf16x8 kf = *(const bf16x8*)(KcL + (sub * 32 + r) * 272 + (ks * 16 + hh * 8) * 2);
          S[sub] = MFMA32(kf, Qf[ks], S[sub]);
        }
#pragma unroll
        for (int i = 0; i < 16; ++i) {
          bool ok = (sub * 32 + crow(i, hh)) <= cmax;
          S[sub][i] = ok ? S[sub][i] : -1e30f;
          mx = fmaxf(mx, S[sub][i]);
        }
      } else {
#pragma unroll
        for (int i = 0; i < 16; ++i) S[sub][i] = -1e30f;
      }
    }
    mx = fmaxf(mx, xhalf(mx, r, hh));
    float ps = 0.f;
#pragma unroll
    for (int sub = 0; sub < 4; ++sub) {
      if (sub * 32 <= cmax_w) {
#pragma unroll
        for (int i = 0; i < 16; ++i) {
          float pv = (S[sub][i] > -1e29f) ? ex2(S[sub][i] - mx) : 0.f;
          ps += pv;
          S[sub][i] = pv;
        }
      } else {
#pragma unroll
        for (int i = 0; i < 16; ++i) S[sub][i] = 0.f;
      }
    }
    ps += xhalf(ps, r, hh);
    float inv = 1.f / fmaxf(ps, 1e-30f);
#pragma unroll
    for (int sub = 0; sub < 4; ++sub)
#pragma unroll
      for (int i = 0; i < 16; ++i) S[sub][i] *= inv;
    bf16x8 pf[4][2];
#pragma unroll
    for (int sub = 0; sub < 4; ++sub) {
      pf[sub][0] = pack8(S[sub], 0);
      pf[sub][1] = pack8(S[sub], 1);
      if (sub * 32 <= cmax_w) {
#pragma unroll
        for (int i = 0; i < 16; ++i) {
          float v = S[sub][i];
          v += dpp_xor1(v);
          v += dpp_xor2(v);
          if ((r & 3) == 0) psum[tokl * 129 + sub * 32 + crow(i, hh)] = v;
        }
      } else if ((r & 3) == 0) {
#pragma unroll
        for (int i = 0; i < 16; ++i) psum[tokl * 129 + sub * 32 + crow(i, hh)] = 0.f;
      }
    }
    __builtin_amdgcn_sched_barrier(0);
#pragma unroll
    for (int dt = 0; dt < 4; ++dt)
#pragma unroll
      for (int i = 0; i < 16; ++i) Oc[dt][i] = 0.f;
#pragma unroll
    for (int sub = 0; sub < 4; ++sub) {
      if (sub * 32 <= cmax_w)
#pragma unroll
      for (int dt = 0; dt < 4; ++dt) {
        const char* vrow = VcL + (dt * 32 + r) * 264 + sub * 64 + hh * 8;
        bf16x8 v0 = lds_vfrag(vrow);
        bf16x8 v1 = lds_vfrag(vrow + 32);
        Oc[dt] = MFMA32(v0, pf[sub][0], Oc[dt]);
        Oc[dt] = MFMA32(v1, pf[sub][1], Oc[dt]);
      }
    }
  }
  __syncthreads();
#pragma unroll
  for (int dt = 0; dt < 4; ++dt)
#pragma unroll
    for (int s2 = 0; s2 < 2; ++s2) *(bf16x8*)(OcL + wid * 8192 + (dt * 2 + s2) * 1024 + lane * 16) = pack8(Oc[dt], s2);
  {
    const int tl = lane >> 3, jq = lane & 7;
    const int tk2 = wid * 8 + tl;
    const int t2 = q0 + tk2;
    const int cur = t2 >> 6;
    float my[4];
#pragma unroll
    for (int e = 0; e < 4; ++e) {
      int j = jq * 4 + e;
      float s = 0.f;
#pragma unroll
      for (int dc = -1; dc <= 3; ++dc) {
        int c = 4 * j + dc;
        if (c >= 0 && c < 127) s += psum[tk2 * 129 + c];
      }
      bool forced = (j == 0) || (j == cur) || (j == cur - 1);
      bool val = j <= cur;
      my[e] = forced ? 1e4f : (val ? s : -1.f);
      scs[tk2 * 33 + j] = my[e];
    }
    __syncthreads();
    unsigned bits = 0;
    int cnt[4] = {0, 0, 0, 0};
#pragma unroll 8
    for (int jj = 0; jj < 32; ++jj) {
      float v = scs[tk2 * 33 + jj];
#pragma unroll
      for (int e = 0; e < 4; ++e) {
        int j = jq * 4 + e;
        cnt[e] += ((v > my[e]) || (v == my[e] && jj < j)) ? 1 : 0;
      }
    }
#pragma unroll
    for (int e = 0; e < 4; ++e)
      if (cnt[e] < 16) bits |= 1u << (jq * 4 + e);
    bits |= SWZ_XOR_U(bits, 1);
    bits |= SWZ_XOR_U(bits, 2);
    bits |= SWZ_XOR_U(bits, 4);
    if (jq == 0) smask[tk2] = bits;
  }
  __syncthreads();
  const unsigned mymask = smask[tokl];
  f32x16 O[4];
#pragma unroll
  for (int dt = 0; dt < 4; ++dt)
#pragma unroll
    for (int i = 0; i < 16; ++i) O[dt][i] = 0.f;
  float m = -1e30f, l = 0.f;
  {
    const bf16_t* ksrc = (const bf16_t*)(p.ws + OFF_KSA) + (size_t)(b * 2 + h) * 2048 * 128;
    const bf16_t* vsrc = (const bf16_t*)(p.ws + OFF_VSAT) + (size_t)(b * 2 + h) * 128 * 2048;
    __syncthreads();
    char* const KB = g_shm + 65536;
    char* const VB = g_shm + 100352;
    pf.commit(KB, VB, tid);
    if (1 <= qb) pf.issue(ksrc + (size_t)64 * 128, vsrc + 64, tid);
    __syncthreads();
    const bool late = p.wv >= 4;
    PFrag Pc;
    bool have = false;
    int vprev = 0;
    for (int jb = 0; jb <= qb; ++jb) {
      const int cur = jb & 1, vc = jb % 3;
      if (late && have) { attn_pv<128>(VB + vprev * 18432, O, Pc, r, hh); have = false; }
      const bool sel = (mymask >> jb) & 1u;
      if (__builtin_amdgcn_ballot_w64(sel) != 0ull) {
        const int key0 = jb * 64;
        auto vf = [&](int kl) { return (key0 + kl) <= t; };
        PFrag Pn;
        attn_scores<128>(KB + cur * 17408, Qf, O, m, l, r, hh, sel, jb == qb, jb == 0, vf, Pn);
        if (late) { Pc = Pn; have = true; vprev = vc; }
        else attn_pv<128>(VB + vc * 18432, O, Pn, r, hh);
      }
      if (jb + 1 <= qb) {
        pf.commit(KB + (cur ^ 1) * 17408, VB + ((vc + 1) % 3) * 18432, tid);
        if (jb + 2 <= qb) pf.issue(ksrc + (size_t)(jb + 2) * 64 * 128, vsrc + (jb + 2) * 64, tid);
      }
      __syncthreads();
    }
    if (late && have) attn_pv<128>(VB + vprev * 18432, O, Pc, r, hh);
    __syncthreads();
  }
  {
    const int tid2 = otid(p.wv);
    const int wid = tid2 >> 6, lane = tid2 & 63;
    const int r = lane & 31, hh = lane >> 5;
    const int tokl = wid * 8 + (r >> 2);
    const int t = q0 + tokl;
    const int head = h * 4 + (r & 3);
    const float* gt = (const float*)(p.ws + OFF_GATES) + (size_t)(b * 2048 + t) * 24 + head * 3;
    const float lt = l + xhalf(l, r, hh);
    const float g0 = gt[0], g1 = gt[1] / fmaxf(lt, 1e-30f), g2 = gt[2];
    char* lw = g_shm + 68608 + wid * 8448;
    const size_t tok0 = (size_t)(b * 2048 + q0 + wid * 8);
    uint2 wr_[4][4], zr_[4][4];
    wtile_load<4, 256, 8>((const bf16_t*)(p.ws + OFF_OWIN) + tok0 * 1024 + h * 512, 1024, lw, lane);
#pragma unroll
    for (int dt = 0; dt < 4; ++dt)
#pragma unroll
      for (int g = 0; g < 4; ++g) wr_[dt][g] = *(const uint2*)(lw + r * 264 + (dt * 32 + 8 * g + 4 * hh) * 2);
    wtile_load<4, 256, 8>((const bf16_t*)(p.ws + OFF_ZA) + tok0 * 1024 + h * 512, 1024, lw, lane);
#pragma unroll
    for (int dt = 0; dt < 4; ++dt)
#pragma unroll
      for (int g = 0; g < 4; ++g) zr_[dt][g] = *(const uint2*)(lw + r * 264 + (dt * 32 + 8 * g + 4 * hh) * 2);
#pragma unroll
    for (int dt = 0; dt < 4; ++dt)
#pragma unroll
      for (int g = 0; g < 4; ++g) {
        uint2 w = wr_[dt][g];
        uint2 z = zr_[dt][g];
        float w0 = __uint_as_float(w.x << 16), w1 = __uint_as_float(w.x & 0xffff0000u), w2 = __uint_as_float(w.y << 16), w3 = __uint_as_float(w.y & 0xffff0000u);
        float z0 = __uint_as_float(z.x << 16), z1 = __uint_as_float(z.x & 0xffff0000u), z2 = __uint_as_float(z.y << 16), z3 = __uint_as_float(z.y & 0xffff0000u);
        uint2 c = *(const uint2*)(OcL + wid * 8192 + (dt * 2 + (g >> 1)) * 1024 + lane * 16 + (g & 1) * 8);
        float c0 = __uint_as_float(c.x << 16), c1 = __uint_as_float(c.x & 0xffff0000u), c2 = __uint_as_float(c.y << 16), c3 = __uint_as_float(c.y & 0xffff0000u);
        float a0 = (g0 * c0 + g1 * O[dt][4 * g] + g2 * w0) * z0;
        float a1 = (g0 * c1 + g1 * O[dt][4 * g + 1] + g2 * w1) * z1;
        float a2 = (g0 * c2 + g1 * O[dt][4 * g + 2] + g2 * w2) * z2;
        float a3 = (g0 * c3 + g1 * O[dt][4 * g + 3] + g2 * w3) * z3;
        uint2 o;
        o.x = pack2(a0, a1);
        o.y = pack2(a2, a3);
        *(uint2*)(lw + r * 264 + (dt * 32 + 8 * g + 4 * hh) * 2) = o;
      }
    wtile_store<4, 256, 8>((bf16_t*)(p.ws + OFF_Y) + tok0 * 2048 + h * 512, 2048, lw, lane);
  }
}

DI void phase_mix2(const Params& p) {
  int* ctr = (int*)(p.ws + OFF_MISC + MISC_CTR) + 16;
  if (gridDim.x == 256) {
    const int c = blockIdx.x, bh = c & 15, x = c >> 4;
    item_nsa(p, bh >> 1, bh & 1, 31 - x);
    item_nsa(p, bh >> 1, bh & 1, x);
    return;
  }
  for (;;) {
    int it = next_item(p.wv, ctr);
    if (it >= 512) break;
    int qb = 31 - (it >> 4), bh = it & 15;
    item_nsa(p, bh >> 1, bh & 1, qb);
  }
}

DI void phase_out(const Params& p) {
  const bf16_t* y = (const bf16_t*)(p.ws + OFF_Y);
  const bf16_t* wto = (const bf16_t*)(p.ws + OFF_WTOUT);
  float* rowss = (float*)(p.ws + OFF_MISC + MISC_ROWSS);
  const int tid = otid(p.wv), wid = tid >> 6, lane = tid & 63, wr = wid >> 2, wc = wid & 3, fr = lane & 15, fq = lane >> 4;
  for (int L = blockIdx.x; L < 64 * 8; L += gridDim.x) {
    int pm, pn;
    unit_order(L, 64, 8, pm, pn);
    f32x4 acc[8][4];
    gemm_mainloop(p.wv, y + (size_t)pm * 256 * DM, DM, wto + (size_t)pn * 256 * DM, DM, DM / 64, acc);
    const float* __restrict__ xin = p.x;
    float* __restrict__ xout = p.out;
#pragma unroll
    for (int m = 0; m < 8; ++m) {
      float xv[4][4];
#pragma unroll
      for (int j = 0; j < 4; ++j)
#pragma unroll
        for (int n = 0; n < 4; ++n)
          xv[j][n] = xin[((size_t)pm * 256 + wr * 128 + m * 16 + fq * 4 + j) * DM + pn * 256 + wc * 64 + n * 16 + fr];
#pragma unroll
      for (int j = 0; j < 4; ++j) {
        size_t row = (size_t)pm * 256 + wr * 128 + m * 16 + fq * 4 + j;
        float ss = 0.f;
#pragma unroll
        for (int n = 0; n < 4; ++n) {
          size_t idx = row * DM + pn * 256 + wc * 64 + n * 16 + fr;
          float v = xv[j][n] + acc[m][n][j];
          xout[idx] = v;
          ss += v * v;
        }
        ss += SWZ_XOR_F(ss, 1);
        ss += SWZ_XOR_F(ss, 2);
        ss += SWZ_XOR_F(ss, 4);
        ss += SWZ_XOR_F(ss, 8);
        if (fr == 0) atomicAdd(rowss + row, ss);
      }
    }
  }
}

DI void phase_out_fused(const Params& p) {
  const bf16_t* y = (const bf16_t*)(p.ws + OFF_Y);
  const bf16_t* wto = (const bf16_t*)(p.ws + OFF_WTOUT);
  float* rowss = (float*)(p.ws + OFF_MISC + MISC_ROWSS);
  unsigned* pcnt = (unsigned*)(p.ws + OFF_MISC + MISC_CTR) + 64;
  const int c = blockIdx.x, xcd = c & 7, slot = c >> 3, grp = slot >> 3, pn = slot & 7;
  for (int i = 0; i < 2; ++i) {
    const int pm = i * 32 + xcd * 4 + grp;
    f32x4 acc[8][4];
    gemm_mainloop8<true>(p.wv, y + (size_t)pm * 256 * DM, DM, wto + (size_t)pn * 256 * DM, DM, DM / 64, acc);
    const int lane = olane(), fr = lane & 15, fq = lane >> 4;
    const int wr_s = p.wv >> 2, wc_s = p.wv & 3;
    const size_t ubase = ((size_t)pm * 256 + wr_s * 64) * DM + pn * 256 + wc_s * 32;
    const float* __restrict__ xb = p.x + ubase;
    float* __restrict__ ob = p.out + ubase;
    float* rs = rowss + pm * 256 + wr_s * 64;
    const unsigned lo = (unsigned)(fr * DM + fq * 4);
#define MOFF(m) (((((m) >> 2) * 128) + (((m) & 3) * 16)) * DM)
#define MROW(m) ((((m) >> 2) * 128) + (((m) & 3) * 16))
#define NOFF(n) ((((n) >> 1) * 128) + (((n) & 1) * 16))
    {
#define XLOAD(dst, mb) _Pragma("unroll") for (int mi = 0; mi < 2; ++mi) _Pragma("unroll") for (int n = 0; n < 4; ++n) \
    dst[mi][n] = __builtin_nontemporal_load((const f32x4*)(xb + MOFF((mb) + mi) + NOFF(n) + lo))
#define XADD(src, mb) _Pragma("unroll") for (int mi = 0; mi < 2; ++mi) _Pragma("unroll") for (int n = 0; n < 4; ++n) acc[(mb) + mi][n] += src[mi][n]
      f32x4 xa[2][4], xb2[2][4];
      XLOAD(xa, 0); XLOAD(xb2, 2);
      __builtin_amdgcn_sched_barrier(0);
      XADD(xa, 0); XLOAD(xa, 4);
      __builtin_amdgcn_sched_barrier(0);
      XADD(xb2, 2); XLOAD(xb2, 6);
      __builtin_amdgcn_sched_barrier(0);
      XADD(xa, 4);
      __builtin_amdgcn_sched_barrier(0);
      XADD(xb2, 6);
      __builtin_amdgcn_sched_barrier(0);
#undef XLOAD
#undef XADD
    }
#pragma unroll
    for (int m = 0; m < 8; ++m) {
      float ss = 0.f;
#pragma unroll
      for (int n = 0; n < 4; ++n)
        ss += acc[m][n][0] * acc[m][n][0] + acc[m][n][1] * acc[m][n][1] + acc[m][n][2] * acc[m][n][2] + acc[m][n][3] * acc[m][n][3];
      ss += SWZ_XOR_F(ss, 16);
      ss += xhalf(ss, lane & 31, lane >> 5);
      if (fq == 0) atomicAdd(rs + MROW(m) + fr, ss);
    }
    asm volatile("s_waitcnt vmcnt(0)" ::: "memory");
    __syncthreads();
    if (p.wv == 0 && lane == 0) {
      asm volatile("" ::: "memory");
      __hip_atomic_fetch_add(pcnt + pm, 1u, __ATOMIC_RELAXED, __HIP_MEMORY_SCOPE_AGENT);
      unsigned sp = 0;
      while (__hip_atomic_load(pcnt + pm, __ATOMIC_RELAXED, __HIP_MEMORY_SCOPE_AGENT) < 8u) {
        __builtin_amdgcn_s_sleep(1);
        if (++sp > (1u << 22)) break;
      }
      asm volatile("" ::: "memory");
    }
    __syncthreads();
    f32x4 gv[4];
#pragma unroll
    for (int n = 0; n < 4; ++n) gv[n] = *(const f32x4*)(p.final_g + pn * 256 + wc_s * 32 + NOFF(n) + fq * 4);
    float tot[8];
#pragma unroll
    for (int m = 0; m < 8; ++m) tot[m] = __hip_atomic_load(rs + MROW(m) + fr, __ATOMIC_RELAXED, __HIP_MEMORY_SCOPE_AGENT);
#pragma unroll
    for (int m = 0; m < 8; ++m) {
      const float rstd = rsqrtf(tot[m] * (1.f / DM) + 1e-6f);
#pragma unroll
      for (int n = 0; n < 4; ++n) __builtin_nontemporal_store(acc[m][n] * rstd * gv[n], (f32x4*)(ob + MOFF(m) + NOFF(n) + lo));
    }
#undef MOFF
#undef MROW
#undef NOFF
  }
}

DI void phase_final(const Params& p) {
  const int tid = otid(p.wv), wid = tid >> 6, lane = tid & 63;
  const float* rowss = (const float*)(p.ws + OFF_MISC + MISC_ROWSS);
  const float4* g4 = (const float4*)p.final_g;
  for (int row = blockIdx.x * 8 + wid; row < T_TOK; row += gridDim.x * 8) {
    float rstd = rsqrtf(rowss[row] * (1.f / DM) + 1e-6f);
    float4* o = (float4*)(p.out + (size_t)row * DM);
    float4 v[8], g[8];
#pragma unroll
    for (int i = 0; i < 8; ++i) { v[i] = o[lane + 64 * i]; g[i] = g4[lane + 64 * i]; }
#pragma unroll
    for (int i = 0; i < 8; ++i) {
      float4 t = v[i];
      t.x *= rstd * g[i].x; t.y *= rstd * g[i].y; t.z *= rstd * g[i].z; t.w *= rstd * g[i].w;
      o[lane + 64 * i] = t;
    }
  }
}


#define XB_TMO      128
#define XB_XCNT(j)  (256  + 64 * (j))
#define XB_XSUB(j)  (1280 + 64 * (j))
#define XB_XGEN(j)  (2304 + 64 * (j))
#define XB_TOP      3328
#define XB_TOPGEN   3392
#define XCD_BAR_WORDS 3456
#define XB_SPIN_CAP (1u << 20)
DI unsigned xb_ld(unsigned* p) { return __hip_atomic_load(p, __ATOMIC_RELAXED, __HIP_MEMORY_SCOPE_AGENT); }
DI unsigned xb_add(unsigned* p, unsigned v) { return __hip_atomic_fetch_add(p, v, __ATOMIC_RELAXED, __HIP_MEMORY_SCOPE_AGENT); }
DI unsigned xb_xcc_id() { return (unsigned)__builtin_amdgcn_s_getreg((3 << 11) | 20) & 0xFu; }
#define XB_SPIN(cond, bar) do { unsigned _sp = 0; while (cond) { __builtin_amdgcn_s_sleep(1); \
    if ((++_sp & 255u) == 0u) { if (xb_ld(&(bar)[XB_TMO])) break; if (_sp > XB_SPIN_CAP) { atomicAdd(&(bar)[XB_TMO], 1u); break; } } } } while (0)
DI void xcd_barrier_complete(unsigned* bar, unsigned x, unsigned& nloc, unsigned& nx) {
  const unsigned G = gridDim.x;
  unsigned sum, cnt, mine, sp = 0u;
  for (;;) {
    sum = 0u; cnt = 0u; mine = 0u;
#pragma unroll
    for (unsigned j = 0; j < 16; ++j) { const unsigned c = xb_ld(&bar[XB_XCNT(j)]); sum += c; cnt += (c > 0u) ? 1u : 0u; mine = (j == x) ? c : mine; }
    if (sum == G) break;
    __builtin_amdgcn_s_sleep(1);
    if ((++sp & 255u) == 0u) { if (xb_ld(&bar[XB_TMO])) break; if (sp > XB_SPIN_CAP) { atomicAdd(&bar[XB_TMO], 1u); break; } }
  }
  nloc = mine > 0u ? mine : 1u; nx = cnt > 0u ? cnt : 1u;
}
DI void xcd_barrier(int wv, unsigned* bar, unsigned x, volatile unsigned* st) {
  asm volatile("s_waitcnt vmcnt(0)" ::: "memory");
  __syncthreads();
  if (otid(wv) == 0) {
    __builtin_amdgcn_s_waitcnt(0);
    unsigned nloc = st[0], nx = st[1];
    if (nloc == 0u) { xcd_barrier_complete(bar, x, nloc, nx); st[0] = nloc; st[1] = nx; }
    const unsigned old = xb_add(&bar[XB_XSUB(x)], 1u);
    const unsigned gen = old / nloc;
    if (old + 1u == (gen + 1u) * nloc) {
      __builtin_amdgcn_fence(__ATOMIC_RELEASE, "agent");
      asm volatile("s_waitcnt vmcnt(0)" ::: "memory");
      const unsigned og = xb_add(&bar[XB_TOP], 1u);
      const unsigned tg = og / nx;
      if (og + 1u == (tg + 1u) * nx) xb_add(&bar[XB_TOPGEN], 1u);
      else XB_SPIN(xb_ld(&bar[XB_TOPGEN]) == tg, bar);
      __builtin_amdgcn_fence(__ATOMIC_ACQUIRE, "agent");
      xb_add(&bar[XB_XGEN(x)], 1u);
      asm volatile("s_waitcnt vmcnt(0)" ::: "memory");
    } else {
      XB_SPIN(xb_ld(&bar[XB_XGEN(x)]) == gen, bar);
      __builtin_amdgcn_fence(__ATOMIC_ACQUIRE, "agent");
      asm volatile("s_waitcnt vmcnt(0)" ::: "memory");
    }
  }
  __syncthreads();
}

template <int PH>
__global__ void __launch_bounds__(NTHR) fwd_kernel(Params p) {
  if constexpr (PH == -1) {
    cg::grid_group grid = cg::this_grid();
    p.wv = __builtin_amdgcn_readfirstlane((int)(threadIdx.x >> 6));
    if (p.ws == nullptr) grid.sync();
    unsigned* bar = (unsigned*)(p.ws + OFF_BAR);
    volatile unsigned* st = (volatile unsigned*)(g_shm + SHM_BYTES - 32);
    if (otid(p.wv) == 0) { st[0] = 0u; st[1] = 0u; }
    __syncthreads();
    const unsigned xcc = xb_xcc_id();
    if (otid(p.wv) == 0) (void)xb_add(&bar[XB_XCNT(xcc)], 1u);
    phase_prep(p);
    xcd_barrier(p.wv, bar, xcc, st);
    phase_proj(p);
    xcd_barrier(p.wv, bar, xcc, st);
    phase_mix1(p);
    xcd_barrier(p.wv, bar, xcc, st);
    phase_mix2(p);
    xcd_barrier(p.wv, bar, xcc, st);
    if (gridDim.x == 256) {
      phase_out_fused(p);
    } else {
      phase_out(p);
      xcd_barrier(p.wv, bar, xcc, st);
      phase_final(p);
    }
  } else { p.wv = __builtin_amdgcn_readfirstlane((int)(threadIdx.x >> 6)); if constexpr (PH == 0) phase_prep(p);
  else if constexpr (PH == 1) phase_proj(p);
  else if constexpr (PH == 2) phase_mix1(p);
  else if constexpr (PH == 6) phase_cmp2(p);
  else if constexpr (PH == 3) phase_mix2(p);
  else if constexpr (PH == 4) phase_out(p);
  else phase_final(p); }
}

extern "C" void kernel_launch(void* const* d_in, const int* in_sizes, int n_in, void* d_out, int out_size, void* d_ws, size_t ws_size,
                              hipStream_t stream) {
  Params p{};
  p.x = (const float*)d_in[0];
  p.w_in = (const float*)d_in[1];
  p.k_w1 = (const float*)d_in[2];
  p.k_w2 = (const float*)d_in[3];
  p.v_w1 = (const float*)d_in[4];
  p.v_w2 = (const float*)d_in[5];
  p.k_pos = (const float*)d_in[6];
  p.v_pos = (const float*)d_in[7];
  p.sinks = (const float*)d_in[8];
  p.w_out = (const float*)d_in[9];
  p.norm_g = (const float*)d_in[10];
  p.final_g = (const float*)d_in[11];
  p.out = (float*)d_out;
  p.ws = (char*)d_ws;
#if MULTI_LAUNCH
  const int grid = 256;
  fwd_kernel<0><<<grid, NTHR, 0, stream>>>(p);
  fwd_kernel<1><<<grid, NTHR, 0, stream>>>(p);
  fwd_kernel<2><<<grid, NTHR, 0, stream>>>(p);
  fwd_kernel<6><<<grid, NTHR, 0, stream>>>(p);
  fwd_kernel<3><<<grid, NTHR, 0, stream>>>(p);
  fwd_kernel<4><<<grid, NTHR, 0, stream>>>(p);
  fwd_kernel<5><<<grid, NTHR, 0, stream>>>(p);
#else
  static int grid_blocks = 0;
  if (!grid_blocks) {
    int dev = 0, cus = 0, per_cu = 0;
    hipGetDevice(&dev);
    hipDeviceGetAttribute(&cus, hipDeviceAttributeMultiprocessorCount, dev);
    hipOccupancyMaxActiveBlocksPerMultiprocessor(&per_cu, fwd_kernel<-1>, NTHR, 0);
    if (per_cu < 1) per_cu = 1;
    if (per_cu > 1) per_cu = 1;
    grid_blocks = cus * per_cu;
  }
  hipMemsetAsync((char*)d_ws + OFF_BAR, 0, XCD_BAR_WORDS * 4, stream);
  void* args[] = {&p};
  hipError_t e = hipLaunchCooperativeKernel((void*)fwd_kernel<-1>, dim3(grid_blocks), dim3(NTHR), args, 0, stream);
  if (e != hipSuccess) fprintf(stderr, "cooperative launch failed: %s (grid %d)\n", hipGetErrorString(e), grid_blocks);
#endif
}
```
